# Optimizing an MI355X kernel written in HIP

```python
import math
import jax, jax.numpy as jnp
from jax import lax
import numpy as np

D_MODEL = 2048
BATCH = 32
SEQ = 256
DEPTH = 2
DEC_BATCH = 4
DEC_SEQ = 4096
PAST_LEN = 256

GRID_W = 64
Q_BLOCK = 128
ROPE_BASE = 10000.0
NORM_EPS = 1e-6
HEAD_DIM_A = 128
N_HEADS_A = (D_MODEL // 2) // HEAD_DIM_A
N_KV_HEADS_A = 2
N_HEADS_B = 4
DV_B = (D_MODEL // 4) // N_HEADS_B
DK_B = DV_B // 2
N_FOURIER_GROUPS = 4
FOURIER_GROUP_DIM = (D_MODEL // 4) // N_FOURIER_GROUPS
D_FF = 256 * ((8 * D_MODEL // 3 + 255) // 256)
N_MOD = 6
COLS_QA = N_HEADS_A * HEAD_DIM_A
COLS_KVA = N_KV_HEADS_A * HEAD_DIM_A
COLS_QKB = N_HEADS_B * 2 * DK_B
COLS_VB = N_HEADS_B * DV_B
COLS_C = N_FOURIER_GROUPS * FOURIER_GROUP_DIM
D_IN = COLS_QA + 2 * COLS_KVA + 2 * COLS_QKB + COLS_VB + COLS_C
MIX_OUT = COLS_QA + COLS_VB + COLS_C
SPLIT_AT = (COLS_QA,
            COLS_QA + COLS_KVA,
            COLS_QA + 2 * COLS_KVA,
            COLS_QA + 2 * COLS_KVA + COLS_QKB,
            COLS_QA + 2 * COLS_KVA + 2 * COLS_QKB,
            COLS_QA + 2 * COLS_KVA + 2 * COLS_QKB + COLS_VB)

kernel_name = "hybrid_dit_prefix_ctx_step"


def rms_norm(x, g):
    xf = x.astype(jnp.float32)
    y = xf * lax.rsqrt(jnp.mean(xf * xf, axis=-1, keepdims=True) + NORM_EPS)
    return (y * g.astype(jnp.float32)).astype(x.dtype)


def axial_rope_tables(n, head_dim):
    rows = n // GRID_W
    t_row = jnp.repeat(jnp.arange(rows, dtype=jnp.float32), GRID_W)
    t_col = jnp.tile(jnp.arange(GRID_W, dtype=jnp.float32), rows)
    axis_dim = head_dim // 2
    inv = jnp.power(ROPE_BASE, -jnp.arange(0, axis_dim, 2, dtype=jnp.float32) / axis_dim)
    ar = t_row[:, None] * inv[None, :]
    ac = t_col[:, None] * inv[None, :]
    ang = jnp.concatenate([ar, ar, ac, ac], axis=-1)
    return jnp.cos(ang), jnp.sin(ang)


def apply_rope(x, cos, sin):
    xf = x.astype(jnp.float32)
    a, b, c, d = jnp.split(xf, 4, axis=-1)
    rot = jnp.concatenate([-b, a, -d, c], axis=-1)
    return (xf * cos[None, :, None, :] + rot * sin[None, :, None, :]).astype(x.dtype)


def sweep_query_blocks(fn, *qs):
    b, n = qs[0].shape[:2]
    nb = n // Q_BLOCK
    blocks = tuple(jnp.moveaxis(q.reshape(b, nb, Q_BLOCK, *q.shape[2:]), 1, 0) for q in qs)
    out = lax.map(lambda args: fn(*args), blocks)
    return jnp.moveaxis(out, 0, 1).reshape(b, n, *out.shape[3:])


def gqa_attention(q, k, v):
    b = q.shape[0]
    grp = N_HEADS_A // N_KV_HEADS_A
    scale = HEAD_DIM_A ** -0.5

    def block(qb):
        qb = qb.reshape(b, Q_BLOCK, N_KV_HEADS_A, grp, HEAD_DIM_A)
        s = jnp.einsum('bqkgd,bmkd->bkgqm', qb, k).astype(jnp.float32) * scale
        pr = jax.nn.softmax(s, axis=-1).astype(v.dtype)
        o = jnp.einsum('bkgqm,bmkd->bqkgd', pr, v)
        return o.reshape(b, Q_BLOCK, N_HEADS_A * HEAD_DIM_A)

    return sweep_query_blocks(block, q)


def diff_attention(q1, q2, k1, k2, v, lam):
    scale = DK_B ** -0.5

    def block(q1b, q2b):
        s1 = jnp.einsum('bqhd,bmhd->bhqm', q1b, k1).astype(jnp.float32) * scale
        s2 = jnp.einsum('bqhd,bmhd->bhqm', q2b, k2).astype(jnp.float32) * scale
        w = jax.nn.softmax(s1, axis=-1) - lam * jax.nn.softmax(s2, axis=-1)
        return jnp.einsum('bhqm,bmhd->bqhd', w.astype(v.dtype), v)

    return sweep_query_blocks(block, q1, q2)


def fourier_mix(f):
    b, n = f.shape[:2]
    z = jnp.fft.fft2(f.astype(jnp.float32), axes=(1, 3), norm='ortho').real
    return z.astype(f.dtype).reshape(b, n, N_FOURIER_GROUPS * FOURIER_GROUP_DIM)


def conv_ffn(h, w_gate, w_up, conv_w, conv_b, w_down):
    g = h @ w_gate
    gp = jnp.pad(g, ((0, 0), (1, 1), (0, 0)))
    g = gp[:, :-2] * conv_w[0] + gp[:, 1:-1] * conv_w[1] + gp[:, 2:] * conv_w[2] + conv_b
    return (jax.nn.silu(g) * (h @ w_up)) @ w_down


def token_mix(h, p, l, rope_a, rope_b, ctx):
    b, n = h.shape[:2]
    u = h @ p['w_in'][l]
    qa, ka, va, qb, kb, vb, f = jnp.split(u, SPLIT_AT, axis=-1)
    qa = rms_norm(qa.reshape(b, n, N_HEADS_A, HEAD_DIM_A), p['attn_q_norm_g'][l])
    ka = rms_norm(ka.reshape(b, n, N_KV_HEADS_A, HEAD_DIM_A), p['attn_k_norm_g'][l])
    va = va.reshape(b, n, N_KV_HEADS_A, HEAD_DIM_A)
    qb = qb.reshape(b, n, 2 * N_HEADS_B, DK_B)
    kb = kb.reshape(b, n, N_HEADS_B, 2 * DK_B)
    vb = vb.reshape(b, n, N_HEADS_B, DV_B)
    if ctx is None:
        new_ctx = (ka, va, kb, vb)
        keys_a, vals_a, keys_b, vals_b = ka, va, kb, vb
    else:
        cos_a, sin_a = rope_a
        cos_b, sin_b = rope_b
        qa = apply_rope(qa, cos_a, sin_a)
        ka = apply_rope(ka, cos_a, sin_a)
        qb = apply_rope(qb, cos_b, sin_b)
        kb = apply_rope(kb.reshape(b, n, 2 * N_HEADS_B, DK_B), cos_b, sin_b).reshape(b, n, N_HEADS_B, 2 * DK_B)
        ck_a, cv_a, ck_b, cv_b = ctx
        keys_a = jnp.concatenate([ck_a, ka], axis=1)
        vals_a = jnp.concatenate([cv_a, va], axis=1)
        keys_b = jnp.concatenate([ck_b, kb], axis=1)
        vals_b = jnp.concatenate([cv_b, vb], axis=1)
        new_ctx = None
    m = keys_b.shape[1]
    att_a = gqa_attention(qa, keys_a, vals_a)
    lam_init = 0.8 - 0.6 * math.exp(-0.3 * l)
    lam = (jnp.exp(jnp.sum(p['diff_lambda_q1'][l].astype(jnp.float32) * p['diff_lambda_k1'][l].astype(jnp.float32)))
           - jnp.exp(jnp.sum(p['diff_lambda_q2'][l].astype(jnp.float32) * p['diff_lambda_k2'][l].astype(jnp.float32)))
           + lam_init)
    qb5 = qb.reshape(b, n, N_HEADS_B, 2, DK_B)
    kb5 = keys_b.reshape(b, m, N_HEADS_B, 2, DK_B)
    att_b = diff_attention(qb5[..., 0, :], qb5[..., 1, :], kb5[..., 0, :], kb5[..., 1, :], vals_b, lam)
    att_b = (rms_norm(att_b, p['diff_subnorm_g'][l]) * (1.0 - lam_init)).reshape(b, n, COLS_VB)
    four = fourier_mix(f.reshape(b, n, N_FOURIER_GROUPS, FOURIER_GROUP_DIM))
    out = jnp.concatenate([att_a, att_b, four], axis=-1) @ p['w_out'][l]
    return out, new_ctx


def trunk_layer(x, cvec, p, l, rope_a, rope_b, ctx):
    mod = (jax.nn.silu(cvec) @ p['w_ada'][l] + p['b_ada'][l]).reshape(cvec.shape[0], N_MOD, D_MODEL)
    sh1, sc1, g1, sh2, sc2, g2 = [mod[:, i, None, :] for i in range(N_MOD)]
    h = rms_norm(x, p['norm1_g'][l]) * (1.0 + sc1) + sh1
    mix, new_ctx = token_mix(h, p, l, rope_a, rope_b, ctx)
    x = x + g1 * mix
    h = rms_norm(x, p['norm2_g'][l]) * (1.0 + sc2) + sh2
    x = x + g2 * conv_ffn(h, p['ffn_w_gate'][l], p['ffn_w_up'][l], p['ffn_conv_w'][l],
                          p['ffn_conv_b'][l], p['ffn_w_down'][l])
    return x, new_ctx


def setup_inputs(seed: int = 0) -> dict:
    key = jax.random.key(seed)
    ks = jax.random.split(key, 32)

    def nrm(k, shape, s=1.0):
        return jax.random.normal(k, shape, jnp.float32) * s

    return {
        'x_prompt': nrm(ks[0], (BATCH, SEQ, D_MODEL)),
        'x_sample': nrm(ks[1], (DEC_BATCH, DEC_SEQ, D_MODEL)),
        'cache_attn_k': nrm(ks[2], (DEC_BATCH, DEPTH, PAST_LEN, N_KV_HEADS_A, HEAD_DIM_A)),
        'cache_attn_v': nrm(ks[3], (DEC_BATCH, DEPTH, PAST_LEN, N_KV_HEADS_A, HEAD_DIM_A)),
        'cache_diff_k': nrm(ks[4], (DEC_BATCH, DEPTH, PAST_LEN, N_HEADS_B, 2 * DK_B)),
        'cache_diff_v': nrm(ks[5], (DEC_BATCH, DEPTH, PAST_LEN, N_HEADS_B, DV_B)),
        'c': nrm(ks[6], (DEC_BATCH, D_MODEL)),
        'c_ctx': nrm(ks[7], (D_MODEL,)),
        'norm1_g': 1.0 + nrm(ks[8], (DEPTH, D_MODEL), 0.02),
        'norm2_g': 1.0 + nrm(ks[9], (DEPTH, D_MODEL), 0.02),
        'w_ada': nrm(ks[10], (DEPTH, D_MODEL, N_MOD * D_MODEL), 0.5 * D_MODEL ** -0.5),
        'b_ada': nrm(ks[11], (DEPTH, N_MOD * D_MODEL), 0.01),
        'w_in': nrm(ks[12], (DEPTH, D_MODEL, D_IN), D_MODEL ** -0.5),
        'attn_q_norm_g': 1.0 + nrm(ks[13], (DEPTH, HEAD_DIM_A), 0.02),
        'attn_k_norm_g': 1.0 + nrm(ks[14], (DEPTH, HEAD_DIM_A), 0.02),
        'diff_lambda_q1': nrm(ks[15], (DEPTH, DK_B), 0.1),
        'diff_lambda_k1': nrm(ks[16], (DEPTH, DK_B), 0.1),
        'diff_lambda_q2': nrm(ks[17], (DEPTH, DK_B), 0.1),
        'diff_lambda_k2': nrm(ks[18], (DEPTH, DK_B), 0.1),
        'diff_subnorm_g': 1.0 + nrm(ks[19], (DEPTH, DV_B), 0.02),
        'w_out': nrm(ks[20], (DEPTH, MIX_OUT, D_MODEL), MIX_OUT ** -0.5),
        'ffn_w_gate': nrm(ks[21], (DEPTH, D_MODEL, D_FF), D_MODEL ** -0.5),
        'ffn_w_up': nrm(ks[22], (DEPTH, D_MODEL, D_FF), D_MODEL ** -0.5),
        'ffn_conv_w': nrm(ks[23], (DEPTH, 3, D_FF), 3 ** -0.5),
        'ffn_conv_b': nrm(ks[24], (DEPTH, D_FF), 0.01),
        'ffn_w_down': nrm(ks[25], (DEPTH, D_FF, D_MODEL), D_FF ** -0.5),
        'final_norm_g': 1.0 + nrm(ks[26], (D_MODEL,), 0.02),
    }


def reference(x_prompt, x_sample, cache_attn_k, cache_attn_v, cache_diff_k, cache_diff_v, c, c_ctx,
              norm1_g, norm2_g, w_ada, b_ada, w_in, attn_q_norm_g, attn_k_norm_g,
              diff_lambda_q1, diff_lambda_k1, diff_lambda_q2, diff_lambda_k2, diff_subnorm_g,
              w_out, ffn_w_gate, ffn_w_up, ffn_conv_w, ffn_conv_b, ffn_w_down, final_norm_g):
    p = dict(norm1_g=norm1_g, norm2_g=norm2_g, w_ada=w_ada, b_ada=b_ada, w_in=w_in,
             attn_q_norm_g=attn_q_norm_g, attn_k_norm_g=attn_k_norm_g,
             diff_lambda_q1=diff_lambda_q1, diff_lambda_k1=diff_lambda_k1,
             diff_lambda_q2=diff_lambda_q2, diff_lambda_k2=diff_lambda_k2,
             diff_subnorm_g=diff_subnorm_g, w_out=w_out, ffn_w_gate=ffn_w_gate,
             ffn_w_up=ffn_w_up, ffn_conv_w=ffn_conv_w, ffn_conv_b=ffn_conv_b, ffn_w_down=ffn_w_down)

    x = x_prompt
    ctx_cond = c_ctx[None, :]
    ka_l, va_l, kb_l, vb_l = [], [], [], []
    for l in range(DEPTH):
        x, (ka, va, kb, vb) = trunk_layer(x, ctx_cond, p, l, None, None, None)
        ka_l.append(ka)
        va_l.append(va)
        kb_l.append(kb)
        vb_l.append(vb)
    y_prompt = rms_norm(x, final_norm_g)
    new_attn_k = jnp.stack(ka_l, axis=1)
    new_attn_v = jnp.stack(va_l, axis=1)
    new_diff_k = jnp.stack(kb_l, axis=1)
    new_diff_v = jnp.stack(vb_l, axis=1)

    n_lat = x_sample.shape[1]
    rope_a = axial_rope_tables(n_lat, HEAD_DIM_A)
    rope_b = axial_rope_tables(n_lat, DK_B)
    x = x_sample
    for l in range(DEPTH):
        ctx = (cache_attn_k[:, l], cache_attn_v[:, l], cache_diff_k[:, l], cache_diff_v[:, l])
        x, _ = trunk_layer(x, c, p, l, rope_a, rope_b, ctx)
    y_sample = rms_norm(x, final_norm_g)

    return (y_prompt, y_sample, new_attn_k, new_attn_v, new_diff_k, new_diff_v)
```

```cpp
#include <hip/hip_runtime.h>
#include <hip/hip_cooperative_groups.h>
#include <cstdio>
#include <cstdint>
namespace cg = cooperative_groups;

#define LAS __attribute__((address_space(3)))
typedef unsigned short bf16_t;
typedef short bf16x8 __attribute__((ext_vector_type(8)));
typedef short s16x4 __attribute__((ext_vector_type(4)));
typedef float f32x4 __attribute__((ext_vector_type(4)));
typedef float f32x16 __attribute__((ext_vector_type(16)));
typedef unsigned u32x4 __attribute__((ext_vector_type(4)));
typedef unsigned u32x2 __attribute__((ext_vector_type(2)));

constexpr int DM = 2048, NCTX = 8192, NLAT = 16384, T = NCTX + NLAT, DFF = 5632, NGU = 2 * DFF, NIN = 4096, DIN = 3584;
constexpr int KVROWS = NCTX + 4 * 4352;
constexpr float EPS = 1e-6f;
constexpr size_t MiB = 1u << 20;
constexpr size_t WS_CTL = 0;
constexpr size_t CTL_BYTES = 1 * MiB;
constexpr size_t WS_SS = 0;
constexpr size_t WS_CNT = 512 * 1024;
constexpr size_t WS_BAR = 512 * 1024 + 65536;
constexpr size_t WS_MOD = 1 * MiB;
constexpr size_t WS_BIASIN = 2 * MiB;
constexpr size_t WS_BIASGU = 2 * MiB + 512 * 1024;
constexpr size_t WS_ROPE = 3 * MiB;
constexpr size_t WS_LAM = 3 * MiB + 64 * 1024;
constexpr size_t WS_EDGE = 4 * MiB;
constexpr size_t WS_DFTC = 13 * MiB;
constexpr size_t WS_DFTL = 14 * MiB;
constexpr size_t WS_WIN = 78 * MiB;
constexpr size_t WS_WOUT = 110 * MiB;
constexpr size_t WS_WGU = 126 * MiB;
constexpr size_t WS_WDN = 214 * MiB;
constexpr size_t WS_XA = 258 * MiB;
constexpr size_t WS_QA = 354 * MiB;
constexpr size_t WS_QB = 402 * MiB;
constexpr size_t WS_KA = 426 * MiB;
constexpr size_t WS_VA = 439 * MiB;
constexpr size_t WS_KB = 452 * MiB;
constexpr size_t WS_VB = 477 * MiB;
constexpr size_t WS_FTC = 502 * MiB;
constexpr size_t WS_FTL = 518 * MiB;
constexpr size_t WS_MIX = 550 * MiB;
constexpr size_t WS_HFF = 354 * MiB;
constexpr size_t WS_CST = 646 * MiB;
constexpr size_t WS_X16 = 652 * MiB;
constexpr size_t WS_END = 748 * MiB;
constexpr size_t WS_SMALL = 3 * MiB + 128 * 1024;
constexpr int SP_N1 = 0, SP_N2 = 4096, SP_QN = 8192, SP_KN = 8448, SP_SUB = 8704, SP_FIN = 8960, SP_CB = 11008, SP_CW = 22272, SP_END = 56064;
constexpr size_t O_Y = 0, O_K = (size_t)T * DM, O_V = O_K + 4194304, O_DK = O_V + 4194304, O_DV = O_DK + 8388608;
constexpr int RING_BYTES = 131072, LDSX_OFF = 131072, LDS_BYTES = 147456;

struct Params {
    const float* in[27];
    float* out;
    unsigned char* ws;
};

__device__ __forceinline__ unsigned cvt_pk_bf16(float lo, float hi) { unsigned r; asm volatile("v_cvt_pk_bf16_f32 %0, %1, %2" : "=v"(r) : "v"(lo), "v"(hi)); return r; }
__device__ __forceinline__ u32x4 pack8(f32x4 a, f32x4 b) { u32x4 w; w.x = cvt_pk_bf16(a[0], a[1]); w.y = cvt_pk_bf16(a[2], a[3]); w.z = cvt_pk_bf16(b[0], b[1]); w.w = cvt_pk_bf16(b[2], b[3]); return w; }
__device__ __forceinline__ float silu_f(float x) { return x * __builtin_amdgcn_rcpf(1.f + __expf(-x)); }
__device__ __forceinline__ float wave_sum(float v) {
#pragma unroll
    for (int o = 1; o < 64; o <<= 1) v += __shfl_xor(v, o);
    return v;
}
#define LDS_WAIT() asm volatile("s_waitcnt lgkmcnt(0)" ::: "memory")
__device__ __forceinline__ unsigned char* opaque(unsigned char* p) { size_t z; asm volatile("s_mov_b64 %0, 0" : "=s"(z)); return p + z; }
__device__ __forceinline__ float* opaque(float* p) { size_t z; asm volatile("s_mov_b64 %0, 0" : "=s"(z)); return p + z; }

__device__ __forceinline__ size_t blk(int row, int col, int nt) { return ((size_t)((row >> 8) * nt + (col >> 6)) << 14) + (size_t)(((row & 255) << 6) + (col & 63)); }
__device__ __forceinline__ int win_srccol(int L) {
    if (L < 1280) {
        const int base = L & ~127, Lh = L & 127, wc = Lh >> 5, fq = (Lh >> 3) & 3, n = (Lh >> 2) & 1, i = Lh & 3;
        const int pi = 16 * wc + 4 * fq + i; return base + (pi < 32 ? pi : pi + 32) + 32 * n;
    }
    if (L >= 1536 && L < 2560) {
        const int base = L & ~63, Ls = L & 63, w1 = Ls >> 5, fq = (Ls >> 3) & 3, n = (Ls >> 2) & 1, i = Ls & 3;
        const int pi = 16 * w1 + 4 * fq + i; return base + (pi < 16 ? pi : pi + 16) + 16 * n;
    }
    return L;
}

namespace pg8 {
constexpr int BM = 256, BK = 64, HALF = 128, HTB = HALF * BK * 2, NXCD = 8, WGM = 4;
__host__ __device__ __forceinline__ int lds_byte(int r, int c) { const int st = (r >> 4) * 2 + (c >> 5), rr = r & 15, cc = c & 31, ob = rr * 64 + cc * 2; return st * 1024 + (ob ^ (((ob >> 9) & 1) << 5)); }
__host__ __device__ __forceinline__ void stage_rc(int b, int& R, int& C) { const int st = b / 1024, sb = b % 1024, swz = sb ^ (((sb >> 9) & 1) << 5); R = (st >> 1) * 16 + swz / 64; C = (st & 1) * 32 + (swz % 64) / 2; }
__host__ __device__ __forceinline__ int perm32(int rho) { const int n = rho >> 4, i = rho & 15; return 8 * (i >> 2) + 4 * n + (i & 3); }
struct Unit { int pm, pn; };
struct Gemm { const bf16_t* A; const bf16_t* Bt; int M, N, K; };
struct StaticOrder {
    int nM, nN, nwg, G, c;
    __device__ void init(int M, int N, int G_, int c_) { nM = M / BM; nN = N / BM; nwg = nM * nN; G = G_; c = c_; }
    __device__ bool next(int i, Unit& u) const {
        const long L = (long)i * G + c; if (L >= nwg) return false;
        int wgid = (int)L; { const int q = nwg / NXCD, r = nwg % NXCD, xcd = wgid % NXCD, off = wgid / NXCD; wgid = (xcd < r ? xcd * (q + 1) : r * (q + 1) + (xcd - r) * q) + off; }
        const int nig = WGM * nN, gid = wgid / nig, fm = gid * WGM, gsz = (nM - fm) < WGM ? (nM - fm) : WGM;
        u.pm = fm + ((wgid % nig) % gsz); u.pn = (wgid % nig) / gsz; return true;
    }
};
struct StridedUnits {
    int c, G, total;
    __device__ bool next(int i, Unit& u) const { const int v = c + i * G; if (v >= total) return false; u.pm = v & 1; u.pn = v >> 1; return true; }
};
struct PanelOrder {
    int c, G;
    __device__ bool next(int i, Unit& u) const { if (G != 256 || i >= 3) return false; const int x = c & 7, j = c >> 3; u.pm = (i * 8 + x) * 4 + (j >> 3); u.pn = j & 7; return true; }
};
struct OneUnit {
    int have, pm, pn;
    __device__ bool next(int i, Unit& u) const { if (i > 0 || !have) return false; u.pm = pm; u.pn = pn; return true; }
};

template <class Epi, class Sched, bool ABLK = false, bool BBLK = false>
__device__ __forceinline__ void gemm_phase(LAS unsigned char* lds, const Gemm g, const Sched& S, const Epi& E) {
    int tid = threadIdx.x; asm volatile("" : "+v"(tid));
    const int wid = __builtin_amdgcn_readfirstlane(tid >> 6), lane = tid & 63, wr = wid >> 2, wc = wid & 3, fr = lane & 15, fq = lane >> 4;
    const int K = g.K, nt = K / BK;
    unsigned voffA[2], voffB[2];
#pragma unroll
    for (int i = 0; i < 2; ++i) { int R, C; stage_rc(tid * 16 + i * 8192, R, C); const int Rb = (R & ~31) + perm32(R & 31);
        voffA[i] = ABLK ? (unsigned)(R * 64 + C) * 2u : (unsigned)(R * K + C) * 2u; voffB[i] = BBLK ? (unsigned)(Rb * 64 + C) * 2u : (unsigned)(Rb * K + C) * 2u; }
    const size_t kstepA = ABLK ? (size_t)32768 : (size_t)(BK * 2), kstepB = BBLK ? (size_t)32768 : (size_t)(BK * 2);
    const size_t hstepA = ABLK ? (size_t)16384 : (size_t)HALF * K * 2, hstepB = BBLK ? (size_t)16384 : (size_t)HALF * K * 2;
    const size_t tstepA = (size_t)2 * HALF * K * 2, tstepB = tstepA;
    const unsigned ldsw = (unsigned)wid * 1024u;
    const int aoff = lds_byte(wr * 64 + fr, fq * 8), boff = lds_byte(wc * 32 + fr, fq * 8);
#define PG8_SA(b, h) (((b) * 2 + (h)) * HTB)
#define PG8_SB(b, h) ((4 + (b) * 2 + (h)) * HTB)
#define PG8_STAGE(bufoff, gbase, voff) do { _Pragma("unroll") for (int _i = 0; _i < 2; ++_i) \
        __builtin_amdgcn_global_load_lds((const unsigned*)((const char*)(gbase) + (voff)[_i]), (LAS unsigned*)(lds + (bufoff) + ldsw + _i * 8192), 16, 0, 0); } while (0)
#define PG8_LDA(dst, b, h) do { _Pragma("unroll") for (int m = 0; m < 4; ++m) _Pragma("unroll") for (int k = 0; k < 2; ++k) dst[m][k] = *(const LAS bf16x8*)(lds + PG8_SA(b, h) + aoff + m * 2048 + k * 1024); } while (0)
#define PG8_LDB(dst, b, h) do { _Pragma("unroll") for (int n = 0; n < 2; ++n) _Pragma("unroll") for (int k = 0; k < 2; ++k) dst[n][k] = *(const LAS bf16x8*)(lds + PG8_SB(b, h) + boff + n * 2048 + k * 1024); } while (0)
#define PG8_MMA(ai, bj, At, Bt) do { __builtin_amdgcn_s_setprio(1); _Pragma("unroll") for (int m = 0; m < 4; ++m) _Pragma("unroll") for (int n = 0; n < 2; ++n) _Pragma("unroll") for (int k = 0; k < 2; ++k) \
        acc[ai][bj][m][n] = __builtin_amdgcn_mfma_f32_16x16x32_bf16(Bt[n][k], At[m][k], acc[ai][bj][m][n], 0, 0, 0); __builtin_amdgcn_s_setprio(0); } while (0)
#define PG8_WAIT_V(n) asm volatile("s_waitcnt vmcnt(" #n ")" ::: "memory")
#define PG8_WAIT_L(n) asm volatile("s_waitcnt lgkmcnt(" #n ")" ::: "memory")
#define PG8_BAR __builtin_amdgcn_s_barrier()
#define PG8_SCHED __builtin_amdgcn_sched_barrier(0)
    Unit cur, nxt; int ui = 0;
    if (!S.next(0, cur)) return;
    f32x4 acc[2][2][4][2];
#pragma unroll
    for (int a = 0; a < 2; ++a)
#pragma unroll
        for (int b = 0; b < 2; ++b)
#pragma unroll
            for (int m = 0; m < 4; ++m)
#pragma unroll
                for (int n = 0; n < 2; ++n) acc[a][b][m][n] = (f32x4){0.f, 0.f, 0.f, 0.f};
    bf16x8 At[4][2], B0[2][2], B1[2][2];
    const char* cA = (const char*)g.A + (size_t)cur.pm * tstepA; const char* cB = (const char*)g.Bt + (size_t)cur.pn * tstepB;
    PG8_STAGE(PG8_SB(0, 0), cB, voffB); PG8_STAGE(PG8_SB(0, 1), cB + hstepB, voffB); PG8_STAGE(PG8_SA(0, 0), cA, voffA); PG8_STAGE(PG8_SA(0, 1), cA + hstepA, voffA);
    if (wr == 1) PG8_BAR;
    PG8_WAIT_V(2); PG8_BAR;
    PG8_STAGE(PG8_SB(1, 0), cB + kstepB, voffB); PG8_STAGE(PG8_SA(1, 0), cA + kstepA, voffA); PG8_STAGE(PG8_SB(1, 1), cB + hstepB + kstepB, voffB);
    PG8_WAIT_V(6); PG8_BAR;
    for (;;) {
        const bool has_next = S.next(ui + 1, nxt);
        const char* nA = has_next ? (const char*)g.A + (size_t)nxt.pm * tstepA : cA; const char* nB = has_next ? (const char*)g.Bt + (size_t)nxt.pn * tstepB : cB;
        for (int t = 0; t < nt; t += 2) {
            const bool last = (t == nt - 2);
            const char* a1 = cA + (size_t)(t + 1) * kstepA;
            const char* a2 = last ? nA : cA + (size_t)(t + 2) * kstepA; const char* b2 = last ? nB : cB + (size_t)(t + 2) * kstepB;
            const char* a3 = a2 + kstepA; const char* b3 = b2 + kstepB;
            PG8_LDB(B0, 0, 0); PG8_LDB(B1, 0, 1); PG8_SCHED; PG8_LDA(At, 0, 0); PG8_STAGE(PG8_SA(1, 1), a1 + hstepA, voffA);
            PG8_WAIT_V(8); PG8_WAIT_L(0); PG8_BAR; PG8_MMA(0, 0, At, B0); PG8_MMA(0, 1, At, B1); PG8_BAR; PG8_SCHED;
            PG8_LDA(At, 0, 1); PG8_STAGE(PG8_SB(0, 0), b2, voffB); PG8_STAGE(PG8_SB(0, 1), b2 + hstepB, voffB); PG8_STAGE(PG8_SA(0, 0), a2, voffA);
            PG8_WAIT_V(8); PG8_WAIT_L(0); PG8_BAR; PG8_MMA(1, 0, At, B0); PG8_MMA(1, 1, At, B1); PG8_BAR; PG8_SCHED;
            PG8_LDB(B0, 1, 0); PG8_LDB(B1, 1, 1); PG8_SCHED; PG8_LDA(At, 1, 0); PG8_STAGE(PG8_SA(0, 1), a2 + hstepA, voffA);
            PG8_WAIT_V(8); PG8_WAIT_L(0); PG8_BAR; PG8_MMA(0, 0, At, B0); PG8_MMA(0, 1, At, B1); PG8_BAR; PG8_SCHED;
            PG8_LDA(At, 1, 1); PG8_STAGE(PG8_SB(1, 0), b3, voffB); PG8_STAGE(PG8_SB(1, 1), b3 + hstepB, voffB); PG8_STAGE(PG8_SA(1, 0), a3, voffA);
            PG8_WAIT_V(8); PG8_WAIT_L(0); PG8_BAR; PG8_MMA(1, 0, At, B0); PG8_MMA(1, 1, At, B1); PG8_BAR; PG8_SCHED;
        }
        if (wr == 0) PG8_BAR;
        { int ln = threadIdx.x; asm volatile("" : "+v"(ln)); ln &= 63; E(acc, cur, wr, wc, ln & 15, ln >> 4, lds + LDSX_OFF, ln); }
        if (!has_next) break;
#pragma unroll
        for (int a = 0; a < 2; ++a)
#pragma unroll
            for (int b = 0; b < 2; ++b)
#pragma unroll
                for (int m = 0; m < 4; ++m)
#pragma unroll
                    for (int n = 0; n < 2; ++n) acc[a][b][m][n] = (f32x4){0.f, 0.f, 0.f, 0.f};
        cur = nxt; cA = nA; cB = nB; ++ui;
        if (wr == 1) PG8_BAR;
    }
    PG8_WAIT_V(0);
    PG8_BAR;
#undef PG8_SA
#undef PG8_SB
#undef PG8_STAGE
#undef PG8_LDA
#undef PG8_LDB
#undef PG8_MMA
#undef PG8_WAIT_V
#undef PG8_WAIT_L
#undef PG8_BAR
#undef PG8_SCHED
}
}
using pg8::Unit;

__device__ __forceinline__ int kvrow_of(int row) { return row < NCTX ? row : NCTX + ((row - NCTX) >> 12) * 4352 + 256 + ((row - NCTX) & 4095); }

struct EpiIn {
    unsigned char* ws_; float* out_; int l;
    __device__ __forceinline__ void operator()(f32x4 (&acc)[2][2][4][2], const Unit& u, int wr, int wc, int fr, int fq, LAS unsigned char* ldsx, int lane) const {
        unsigned char* w = opaque(ws_);
        const float* ss = (const float*)(w + WS_SS) + (size_t)(2 * l) * T;
        const float* bias = (const float*)(w + WS_BIASIN) + (size_t)l * 5 * NIN;
        const int pm = u.pm, pn = u.pn; const bool lat = pm >= 32; const int cond = lat ? 1 + ((pm - 32) >> 4) : 0;
        const int cl = wc * 32 + 8 * fq;
        {
            f32x4 bv[2][2];
#pragma unroll
            for (int bj = 0; bj < 2; ++bj)
#pragma unroll
                for (int n = 0; n < 2; ++n) bv[bj][n] = *(const f32x4*)(bias + cond * NIN + pn * 256 + bj * 128 + cl + 4 * n);
#pragma unroll
            for (int ai = 0; ai < 2; ++ai)
#pragma unroll
                for (int m = 0; m < 4; ++m) { const int row = pm * 256 + ai * 128 + wr * 64 + m * 16 + fr; const float rs = rsqrtf(ss[row] * (1.f / DM) + EPS);
#pragma unroll
                    for (int bj = 0; bj < 2; ++bj)
#pragma unroll
                        for (int n = 0; n < 2; ++n) acc[ai][bj][m][n] = acc[ai][bj][m][n] * rs + bv[bj][n]; }
        }
        if (pn <= 4) {
            LAS float* P = (LAS float*)ldsx;
#pragma unroll
            for (int ai = 0; ai < 2; ++ai)
#pragma unroll
                for (int m = 0; m < 4; ++m)
#pragma unroll
                    for (int bj = 0; bj < 2; ++bj) { const f32x4 a = acc[ai][bj][m][0], b = acc[ai][bj][m][1];
                        float s = (a[0] * a[0] + a[1] * a[1]) + (a[2] * a[2] + a[3] * a[3]) + (b[0] * b[0] + b[1] * b[1]) + (b[2] * b[2] + b[3] * b[3]);
                        s += __shfl_xor(s, 16); s += __shfl_xor(s, 32);
                        if (fq == 0) P[((ai * 128 + wr * 64 + m * 16 + fr) * 2 + bj) * 4 + wc] = s; }
            LDS_WAIT(); __builtin_amdgcn_s_barrier(); asm volatile("" ::: "memory");
            const bool isk = (pn == 4);
            const float* gg = (const float*)(w + WS_SMALL) + (isk ? SP_KN : SP_QN) + l * 128;
            const float* rope = (const float*)(w + WS_ROPE);
            bf16_t* QA = (bf16_t*)(w + WS_QA); bf16_t* KA = (bf16_t*)(w + WS_KA); float* oK = opaque(out_) + O_K;
            const int pb = (wc < 2) ? (16 * wc + 4 * fq) : (16 * wc + 4 * fq + 32);
            const f32x4 g0 = *(const f32x4*)(gg + pb), g1 = *(const f32x4*)(gg + pb + 32);
            const int j0 = (16 * wc + 4 * fq) & 31;
#pragma unroll
            for (int ai = 0; ai < 2; ++ai)
#pragma unroll
                for (int m = 0; m < 4; ++m) { const int rt = ai * 128 + wr * 64 + m * 16 + fr, row = pm * 256 + rt;
                    f32x4 cs = (f32x4){1.f, 1.f, 1.f, 1.f}, sn = (f32x4){0.f, 0.f, 0.f, 0.f};
                    if (lat) { const int nt_ = (row - NCTX) & 4095; const int pos = (wc < 2) ? (nt_ >> 6) : (nt_ & 63);
                        cs = *(const f32x4*)(rope + pos * 32 + j0); sn = *(const f32x4*)(rope + 2048 + pos * 32 + j0); }
#pragma unroll
                    for (int bj = 0; bj < 2; ++bj) {
                        const f32x4 pp = *(const LAS f32x4*)(P + (rt * 2 + bj) * 4);
                        const float rh = rsqrtf(((pp[0] + pp[1]) + (pp[2] + pp[3])) * (1.f / 128.f) + EPS);
                        const f32x4 v0 = acc[ai][bj][m][0] * rh * g0, v1 = acc[ai][bj][m][1] * rh * g1;
                        const f32x4 o0 = v0 * cs - v1 * sn, o1 = v1 * cs + v0 * sn;
                        const u32x4 wv = pack8(o0, o1);
                        if (!isk) *(u32x4*)(QA + (size_t)row * 1024 + pn * 256 + bj * 128 + cl) = wv;
                        else { *(u32x4*)(KA + (size_t)kvrow_of(row) * 256 + bj * 128 + cl) = wv;
                            if (!lat) { float* o = oK + ((size_t)((pm * 2 + l) * 256 + rt)) * 256 + bj * 128 + pb; *(f32x4*)o = v0; *(f32x4*)(o + 32) = v1; } }
                    } }
        } else if (pn == 5 || pn == 10 || pn == 11) {
            const bool isa = (pn == 5); const int ld = isa ? 256 : 512; const int cb = isa ? 0 : (pn - 10) * 256;
            bf16_t* dst = (bf16_t*)(w + (isa ? WS_VA : WS_VB)); float* od = opaque(out_) + (isa ? O_V : O_DV);
#pragma unroll
            for (int ai = 0; ai < 2; ++ai)
#pragma unroll
                for (int m = 0; m < 4; ++m) { const int rt = ai * 128 + wr * 64 + m * 16 + fr, row = pm * 256 + rt; const size_t kr = (size_t)kvrow_of(row);
#pragma unroll
                    for (int bj = 0; bj < 2; ++bj) { const f32x4 v0 = acc[ai][bj][m][0], v1 = acc[ai][bj][m][1];
                        *(u32x4*)(dst + kr * ld + cb + bj * 128 + cl) = pack8(v0, v1);
                        if (!lat) { float* o = od + ((size_t)((pm * 2 + l) * 256 + rt)) * ld + cb + bj * 128 + cl; *(f32x4*)o = v0; *(f32x4*)(o + 4) = v1; } } }
        } else if (pn >= 6 && pn <= 9) {
            const bool isk = pn >= 8; const int cb = (pn & 1) * 256;
            const int w1 = wc & 1, pi0 = 16 * w1 + 4 * fq, pb = w1 ? pi0 + 16 : pi0, j0 = pi0 & 15;
            const float* rb = (const float*)(w + WS_ROPE) + 4096;
            bf16_t* QB = (bf16_t*)(w + WS_QB); bf16_t* KB = (bf16_t*)(w + WS_KB); float* oDK = opaque(out_) + O_DK;
#pragma unroll
            for (int ai = 0; ai < 2; ++ai)
#pragma unroll
                for (int m = 0; m < 4; ++m) { const int rt = ai * 128 + wr * 64 + m * 16 + fr, row = pm * 256 + rt;
                    f32x4 cs = (f32x4){1.f, 1.f, 1.f, 1.f}, sn = (f32x4){0.f, 0.f, 0.f, 0.f};
                    if (lat) { const int nt_ = (row - NCTX) & 4095; const int pos = w1 ? (nt_ & 63) : (nt_ >> 6);
                        cs = *(const f32x4*)(rb + pos * 16 + j0); sn = *(const f32x4*)(rb + 1024 + pos * 16 + j0); }
#pragma unroll
                    for (int bj = 0; bj < 2; ++bj) { const f32x4 v0 = acc[ai][bj][m][0], v1 = acc[ai][bj][m][1];
                        const f32x4 o0 = v0 * cs - v1 * sn, o1 = v1 * cs + v0 * sn;
                        const u32x4 wv = pack8(o0, o1);
                        if (!isk) *(u32x4*)(QB + (size_t)row * 512 + cb + bj * 128 + cl) = wv;
                        else { *(u32x4*)(KB + (size_t)kvrow_of(row) * 512 + cb + bj * 128 + cl) = wv;
                            if (!lat) { float* o = oDK + ((size_t)((pm * 2 + l) * 256 + rt)) * 512 + cb + bj * 128 + (wc >> 1) * 64 + pb; *(f32x4*)o = v0; *(f32x4*)(o + 16) = v1; } }
                    } }
        } else {
            const int cs_ = (pn - 12) >> 1, cm0 = ((pn - 12) & 1) * 256 + cl;
            bf16_t* FTC = (bf16_t*)(w + WS_FTC); bf16_t* FTL = (bf16_t*)(w + WS_FTL);
            if (lat) {
                const int b = (pm - 32) >> 4, n2 = fr;
#pragma unroll
                for (int ai = 0; ai < 2; ++ai) { const int n1 = ((pm - 32) & 15) * 16 + ai * 8 + wr * 4;
                    bf16_t* base = FTL + (size_t)(128 * (n2 >> 3) + (n2 & 7)) * 512 + cs_ * 256 + n1;
#pragma unroll
                    for (int bj = 0; bj < 2; ++bj)
#pragma unroll
                        for (int n = 0; n < 2; ++n) { const int colid = b * 512 + cm0 + bj * 128 + 4 * n;
                            bf16_t* q = base + (size_t)((colid >> 4) * 256 + 32 * ((colid & 15) >> 2)) * 512;
#pragma unroll
                            for (int i = 0; i < 4; ++i) { u32x2 o; o.x = cvt_pk_bf16(acc[ai][bj][0][n][i], acc[ai][bj][1][n][i]); o.y = cvt_pk_bf16(acc[ai][bj][2][n][i], acc[ai][bj][3][n][i]);
                                *(u32x2*)(q + (size_t)(8 * i) * 512) = o; } } }
            } else {
#pragma unroll
                for (int ai = 0; ai < 2; ++ai)
#pragma unroll
                    for (int m = 0; m < 4; ++m) { const int rt = ai * 128 + wr * 64 + m * 16 + fr;
                        bf16_t* base = FTC + (size_t)pm * 512 * 512 + cs_ * 256 + rt; const size_t ld = 512;
#pragma unroll
                        for (int bj = 0; bj < 2; ++bj)
#pragma unroll
                            for (int n = 0; n < 2; ++n) { const f32x4 v = acc[ai][bj][m][n];
                                const unsigned p0 = cvt_pk_bf16(v[0], v[1]), p1 = cvt_pk_bf16(v[2], v[3]);
                                bf16_t* q = base + (size_t)(cm0 + bj * 128 + 4 * n) * ld;
                                q[0] = (bf16_t)(p0 & 0xffff); q[ld] = (bf16_t)(p0 >> 16); q[2 * ld] = (bf16_t)(p1 & 0xffff); q[3 * ld] = (bf16_t)(p1 >> 16); } }
            }
        }
    }
};

struct EpiDft {
    unsigned char* ws_; int lat;
    __device__ __forceinline__ void operator()(f32x4 (&acc)[2][2][4][2], const Unit& u, int wr, int wc, int fr, int fq, LAS unsigned char* ldsx, int lane) const {
        bf16_t* MIX = (bf16_t*)(opaque(ws_) + WS_MIX);
        const int cl = 1536 + (u.pn & 1) * 256 + wc * 32 + 8 * fq;
        const int tok0 = lat ? NCTX + (u.pn >> 1) * 4096 + u.pm * 256 : (u.pn >> 1) * 256;
#pragma unroll
        for (int ai = 0; ai < 2; ++ai)
#pragma unroll
            for (int m = 0; m < 4; ++m) { const int row = tok0 + ai * 128 + wr * 64 + m * 16 + fr;
#pragma unroll
                for (int bj = 0; bj < 2; ++bj) *(u32x4*)(MIX + (size_t)row * DM + cl + bj * 128) = pack8(acc[ai][bj][m][0], acc[ai][bj][m][1]); }
    }
};

struct EpiFft {
    unsigned char* ws_;
    __device__ __forceinline__ void operator()(f32x4 (&acc)[2][2][4][2], const Unit& u, int wr, int wc, int fr, int fq, LAS unsigned char* ldsx, int lane) const {
        bf16_t* MIX = (bf16_t*)(opaque(ws_) + WS_MIX);
        constexpr float C16[16] = {1.f, 0.9238795325112867f, 0.7071067811865476f, 0.3826834323650898f, 0.f, -0.3826834323650898f, -0.7071067811865476f, -0.9238795325112867f,
                                   -1.f, -0.9238795325112867f, -0.7071067811865476f, -0.3826834323650898f, 0.f, 0.3826834323650898f, 0.7071067811865476f, 0.9238795325112867f};
        const int colid = u.pn * 16 + wc * 4 + fq, b = colid >> 9, cm = colid & 511;
#pragma unroll
        for (int m = 0; m < 4; ++m) {
            const int k1 = u.pm * 128 + wr * 64 + m * 16 + fr;
            float yr[16], yi[16];
#pragma unroll
            for (int n2 = 0; n2 < 16; ++n2) { const float ar = acc[0][n2 >> 3][m][(n2 >> 2) & 1][n2 & 3], ai_ = acc[1][n2 >> 3][m][(n2 >> 2) & 1][n2 & 3];
                const float ph = (float)((n2 * k1) & 4095) * (1.f / 4096.f); const float c = __builtin_amdgcn_cosf(ph), sn = __builtin_amdgcn_sinf(ph);
                yr[n2] = c * ar + sn * ai_; yi[n2] = c * ai_ - sn * ar; }
#pragma unroll
            for (int k2 = 0; k2 < 16; ++k2) { float z = 0.f;
#pragma unroll
                for (int n2 = 0; n2 < 16; ++n2) z += C16[(n2 * k2) & 15] * yr[n2] + C16[(n2 * k2 + 12) & 15] * yi[n2];
                MIX[(size_t)(NCTX + b * 4096 + k1 + 256 * k2) * DM + 1536 + cm] = (bf16_t)(cvt_pk_bf16(z, 0.f) & 0xffff); }
        }
    }
};

constexpr size_t WS_PCNT = 512 * 1024 + 8192;
template <bool FROM_IN, bool FINAL, bool OUTF32 = false>
struct EpiRes {
    unsigned char* ws_; float* out_; const float* xin_c; const float* xin_l; int gate_off  ; int ng_off  ; int nsc_off  ; int ss_idx;
    __device__ __forceinline__ void operator()(f32x4 (&acc)[2][2][4][2], const Unit& u, int wr, int wc, int fr, int fq, LAS unsigned char* ldsx, int lane) const {
        unsigned char* w = opaque(ws_); float* Y = opaque(out_);
        const float* gate = (const float*)(w + WS_MOD) + gate_off; const float* nsc = (const float*)(w + WS_MOD) + nsc_off;
        const float* ng = (const float*)(w + WS_SMALL) + ng_off; const bool hasn = ng_off >= 0;
        bf16_t* XA = (bf16_t*)(w + WS_XA); bf16_t* X16 = (bf16_t*)(w + WS_X16); float* ssn = (float*)(w + WS_SS) + (size_t)ss_idx * T;
        const int pm = u.pm, pn = u.pn; const int cond = pm >= 32 ? 1 + ((pm - 32) >> 4) : 0;
        const int c0 = pn * 256 + wc * 32 + 8 * fq;
        f32x4 gv[2][2], gm[2][2];
#pragma unroll
        for (int bj = 0; bj < 2; ++bj)
#pragma unroll
            for (int n = 0; n < 2; ++n) { const int c = c0 + bj * 128 + 4 * n; gv[bj][n] = *(const f32x4*)(gate + cond * 12288 + c);
                if (FINAL) gm[bj][n] = *(const f32x4*)(ng + c);
                else if (hasn) gm[bj][n] = *(const f32x4*)(ng + c) * (*(const f32x4*)(nsc + cond * 12288 + c) + 1.f); else gm[bj][n] = (f32x4){0.f, 0.f, 0.f, 0.f}; }
#pragma unroll
        for (int ai = 0; ai < 2; ++ai)
#pragma unroll
            for (int m = 0; m < 4; ++m) { const int row = pm * 256 + ai * 128 + wr * 64 + m * 16 + fr;
                bf16_t* xb = X16 + (size_t)row * DM + c0; float s = 0.f;
                const float* xi = (row < NCTX ? xin_c + (size_t)row * DM : xin_l + (size_t)(row - NCTX) * DM) + c0;
#pragma unroll
                for (int bj = 0; bj < 2; ++bj) {
                    f32x4 x0, x1;
                    if (FROM_IN) { x0 = *(const f32x4*)(xi + bj * 128); x1 = *(const f32x4*)(xi + bj * 128 + 4); }
                    else { const u32x4 xw = *(const u32x4*)(xb + bj * 128);
                        x0 = (f32x4){__uint_as_float(xw.x << 16), __uint_as_float(xw.x & 0xffff0000u), __uint_as_float(xw.y << 16), __uint_as_float(xw.y & 0xffff0000u)};
                        x1 = (f32x4){__uint_as_float(xw.z << 16), __uint_as_float(xw.z & 0xffff0000u), __uint_as_float(xw.w << 16), __uint_as_float(xw.w & 0xffff0000u)}; }
                    x0 = x0 + gv[bj][0] * acc[ai][bj][m][0]; x1 = x1 + gv[bj][1] * acc[ai][bj][m][1];
                    s += (x0[0] * x0[0] + x0[1] * x0[1]) + (x0[2] * x0[2] + x0[3] * x0[3]) + (x1[0] * x1[0] + x1[1] * x1[1]) + (x1[2] * x1[2] + x1[3] * x1[3]);
                    if (FINAL) { acc[ai][bj][m][0] = x0; acc[ai][bj][m][1] = x1; }
                    else { if (OUTF32) { float* xo = Y + (size_t)row * DM + c0; *(f32x4*)(xo + bj * 128) = x0; *(f32x4*)(xo + bj * 128 + 4) = x1; }
                        else *(u32x4*)(xb + bj * 128) = pack8(x0, x1);
                        if (hasn) *(u32x4*)(XA + blk(row, c0 + bj * 128, 32)) = pack8(x0 * gm[bj][0], x1 * gm[bj][1]); }
                }
                s += __shfl_xor(s, 16); s += __shfl_xor(s, 32);
                if (fq == 0) atomicAdd(ssn + row, s);
            }
        if (FINAL) {
            unsigned* pc = (unsigned*)(w + WS_PCNT) + 64 * pm;
            asm volatile("s_waitcnt vmcnt(0)" ::: "memory");
            __builtin_amdgcn_s_barrier();
            if (threadIdx.x == 0) {
                __hip_atomic_fetch_add(pc, 1u, __ATOMIC_RELEASE, __HIP_MEMORY_SCOPE_AGENT);
                unsigned sp = 0;
                while (__hip_atomic_load(pc, __ATOMIC_ACQUIRE, __HIP_MEMORY_SCOPE_AGENT) < 8u) { __builtin_amdgcn_s_sleep(2); if (++sp > (1u << 22)) break; }
            }
            __builtin_amdgcn_s_barrier(); asm volatile("" ::: "memory");
#pragma unroll
            for (int ai = 0; ai < 2; ++ai)
#pragma unroll
                for (int m = 0; m < 4; ++m) { const int row = pm * 256 + ai * 128 + wr * 64 + m * 16 + fr;
                    const float rs = rsqrtf(__hip_atomic_load(ssn + row, __ATOMIC_RELAXED, __HIP_MEMORY_SCOPE_AGENT) * (1.f / DM) + EPS);
                    float* xo = Y + (size_t)row * DM + c0;
#pragma unroll
                    for (int bj = 0; bj < 2; ++bj) { *(f32x4*)(xo + bj * 128) = acc[ai][bj][m][0] * rs * gm[bj][0]; *(f32x4*)(xo + bj * 128 + 4) = acc[ai][bj][m][1] * rs * gm[bj][1]; } }
        }
    }
};

struct EpiGU {
    unsigned char* ws_; int l;
    __device__ __forceinline__ void operator()(f32x4 (&acc)[2][2][4][2], const Unit& u, int wr, int wc, int fr, int fq, LAS unsigned char* ldsx, int lane) const {
        unsigned char* w = opaque(ws_);
        const float* ss = (const float*)(w + WS_SS) + (size_t)(2 * l + 1) * T;
        const float* bias = (const float*)(w + WS_BIASGU) + (size_t)l * 5 * NGU;
        const int pm = u.pm, pn = u.pn; const bool lat = pm >= 32; const int cond = lat ? 1 + ((pm - 32) >> 4) : 0;
        const int cl = wc * 32 + 8 * fq, ch0 = pn * 128 + cl;
        {
            f32x4 bv[2][2];
#pragma unroll
            for (int bj = 0; bj < 2; ++bj)
#pragma unroll
                for (int n = 0; n < 2; ++n) bv[bj][n] = *(const f32x4*)(bias + cond * NGU + pn * 256 + bj * 128 + cl + 4 * n);
#pragma unroll
            for (int ai = 0; ai < 2; ++ai)
#pragma unroll
                for (int m = 0; m < 4; ++m) { const int row = pm * 256 + ai * 128 + wr * 64 + m * 16 + fr; const float rs = rsqrtf(ss[row] * (1.f / DM) + EPS);
#pragma unroll
                    for (int bj = 0; bj < 2; ++bj)
#pragma unroll
                        for (int n = 0; n < 2; ++n) acc[ai][bj][m][n] = acc[ai][bj][m][n] * rs + bv[bj][n]; }
        }
        LAS float* E = (LAS float*)ldsx;
#pragma unroll
        for (int ai = 0; ai < 2; ++ai) { const int q = 2 * ai + wr;
            if (fr == 0) { *(LAS f32x4*)(E + (q * 2 + 0) * 128 + cl) = acc[ai][0][0][0]; *(LAS f32x4*)(E + (q * 2 + 0) * 128 + cl + 4) = acc[ai][0][0][1]; }
            if (fr == 15) { *(LAS f32x4*)(E + (q * 2 + 1) * 128 + cl) = acc[ai][0][3][0]; *(LAS f32x4*)(E + (q * 2 + 1) * 128 + cl + 4) = acc[ai][0][3][1]; } }
        LDS_WAIT(); __builtin_amdgcn_s_barrier(); asm volatile("" ::: "memory");
        const float* cw = (const float*)(w + WS_SMALL) + SP_CW + (size_t)l * 3 * DFF; const float* cb = (const float*)(w + WS_SMALL) + SP_CB + (size_t)l * DFF;
        bf16_t* HFF = (bf16_t*)(w + WS_HFF); float* EDGE = (float*)(w + WS_EDGE);
        const int srcR = (lane & 48) | ((fr + 15) & 15), srcL = (lane & 48) | ((fr + 1) & 15);
        const int pml = pm - 32;
#pragma unroll
        for (int n = 0; n < 2; ++n) {
            const int ch = ch0 + 4 * n;
            const f32x4 w0 = *(const f32x4*)(cw + ch), w1 = *(const f32x4*)(cw + DFF + ch), w2 = *(const f32x4*)(cw + 2 * DFF + ch), bb = *(const f32x4*)(cb + ch);
#pragma unroll
            for (int ai = 0; ai < 2; ++ai) { const int q = 2 * ai + wr;
                const f32x4 xprev = q > 0 ? *(const LAS f32x4*)(E + ((q - 1) * 2 + 1) * 128 + cl + 4 * n) : (f32x4){0.f, 0.f, 0.f, 0.f};
                const f32x4 xnext = q < 3 ? *(const LAS f32x4*)(E + ((q + 1) * 2 + 0) * 128 + cl + 4 * n) : (f32x4){0.f, 0.f, 0.f, 0.f};
                f32x4 rRp = xprev, rLc;
#pragma unroll
                for (int i = 0; i < 4; ++i) rLc[i] = __shfl(acc[ai][0][0][n][i], srcL);
#pragma unroll
                for (int m = 0; m < 4; ++m) { const int rt = ai * 128 + wr * 64 + m * 16 + fr; const int row = pm * 256 + rt;
                    f32x4 rR, rLn;
#pragma unroll
                    for (int i = 0; i < 4; ++i) { rR[i] = __shfl(acc[ai][0][m][n][i], srcR);
                        if (m < 3) rLn[i] = __shfl(acc[ai][0][m + 1][n][i], srcL); else rLn[i] = xnext[i]; }
                    const f32x4 prev = (fr == 0) ? rRp : rR;
                    const f32x4 next = (fr == 15) ? rLn : rLc;
                    const f32x4 cv = prev * w0 + acc[ai][0][m][n] * w1 + next * w2 + bb;
                    f32x4 hv;
#pragma unroll
                    for (int i = 0; i < 4; ++i) hv[i] = silu_f(cv[i]) * acc[ai][1][m][n][i];
                    bool skip = false;
                    if (lat && (rt == 0 || rt == 255)) {
                        const int side = rt == 0 ? 0 : 1;
                        float* e = EDGE + ((size_t)(pml * 2 + side) * 3) * DFF + ch;
                        *(f32x4*)e = cv; *(f32x4*)(e + DFF) = acc[ai][0][m][n]; *(f32x4*)(e + 2 * DFF) = acc[ai][1][m][n];
                        skip = side == 0 ? ((pml & 15) != 0) : ((pml & 15) != 15);
                    }
                    if (!skip) { u32x2 o; o.x = cvt_pk_bf16(hv[0], hv[1]); o.y = cvt_pk_bf16(hv[2], hv[3]); *(u32x2*)(HFF + blk(row, ch, 88)) = o; }
                    rRp = rR; rLc = rLn;
                }
            }
        }
    }
};

namespace att {
constexpr int KVBLK = 64;
constexpr size_t SHM_V = KVBLK * 128 * 2, SHM_K = KVBLK * 128 * 2;
constexpr float THR = 8.f;
#define KSWZ(row, colB) ((row) * 256 + ((colB) ^ (((row) & 7) << 4)))
#define SBAR() __builtin_amdgcn_sched_barrier(0)
__device__ __forceinline__ int crow(int r, int hi) { return (r & 3) + 8 * (r >> 2) + 4 * hi; }
__device__ __forceinline__ void partialSM(f32x16& p0, f32x16& p1, float& m_reg, float& mn, float& alpha, const float C, const float thr) {
    float pmax = p0[0];
#pragma unroll
    for (int r = 1; r < 16; ++r) pmax = fmaxf(pmax, p0[r]);
#pragma unroll
    for (int r = 0; r < 16; ++r) pmax = fmaxf(pmax, p1[r]);
    { auto rr = __builtin_amdgcn_permlane32_swap(__float_as_uint(pmax), __float_as_uint(pmax), false, false);
      pmax = fmaxf(__uint_as_float(rr[0]), __uint_as_float(rr[1])); }
    if (__builtin_expect(__all(pmax - m_reg <= thr), 1)) { mn = m_reg; alpha = 1.f; }
    else { mn = fmaxf(m_reg, pmax); alpha = __builtin_amdgcn_exp2f((m_reg - mn) * C); m_reg = mn; }
    const float mnC = -mn * C;
#pragma unroll
    for (int r = 0; r < 16; ++r) p0[r] = fmaf(p0[r], C, mnC);
#pragma unroll
    for (int r = 0; r < 16; ++r) p1[r] = fmaf(p1[r], C, mnC);
#pragma unroll
    for (int r = 0; r < 16; ++r) p0[r] = __builtin_amdgcn_exp2f(p0[r]);
}
__device__ __forceinline__ void finishSM(f32x16& p0, f32x16& p1, float alpha, float& l_reg, bf16x8& pa0, bf16x8& pa1, bf16x8& pa2, bf16x8& pa3) {
#pragma unroll
    for (int r = 0; r < 16; ++r) p1[r] = __builtin_amdgcn_exp2f(p1[r]);
    float ps = 0;
#pragma unroll
    for (int r = 0; r < 16; ++r) ps += p0[r];
#pragma unroll
    for (int r = 0; r < 16; ++r) ps += p1[r];
    { auto rr = __builtin_amdgcn_permlane32_swap(__float_as_uint(ps), __float_as_uint(ps), false, false);
      ps = __uint_as_float(rr[0]) + __uint_as_float(rr[1]); }
    l_reg = l_reg * alpha + ps;
#define PK4(P, BASE, OUT) do { unsigned a0 = cvt_pk_bf16(P[BASE + 0], P[BASE + 1]), a1 = cvt_pk_bf16(P[BASE + 2], P[BASE + 3]);   \
    unsigned b0 = cvt_pk_bf16(P[BASE + 4], P[BASE + 5]), b1 = cvt_pk_bf16(P[BASE + 6], P[BASE + 7]);                              \
    auto r0 = __builtin_amdgcn_permlane32_swap(a0, b0, false, false); auto r1 = __builtin_amdgcn_permlane32_swap(a1, b1, false, false); \
    u32x4 w = {r0[0], r1[0], r0[1], r1[1]}; OUT = *reinterpret_cast<bf16x8*>(&w); } while (0)
    PK4(p0, 0, pa0); PK4(p0, 8, pa1); PK4(p1, 0, pa2); PK4(p1, 8, pa3);
#undef PK4
}
template <int DH>
__device__ __forceinline__ void qkt(f32x16& p0, f32x16& p1, const char* Ks, const bf16x8* qr, int r32, int hi, int koff) {
    p0 = f32x16{}; p1 = f32x16{};
#pragma unroll
    for (int d0 = 0; d0 < DH; ++d0) { const int cb = (d0 * 16 + hi * 8) * 2 + koff;
        const bf16x8 b0 = *reinterpret_cast<const bf16x8*>(Ks + KSWZ(r32, cb));
        const bf16x8 b1 = *reinterpret_cast<const bf16x8*>(Ks + KSWZ(32 + r32, cb));
        p0 = __builtin_amdgcn_mfma_f32_32x32x16_bf16(b0, qr[d0], p0, 0, 0, 0);
        p1 = __builtin_amdgcn_mfma_f32_32x32x16_bf16(b1, qr[d0], p1, 0, 0, 0); }
}
__device__ __forceinline__ int v_st(int k, int c) { const int kk = (k & ~0xC) | ((k & 4) << 1) | ((k & 8) >> 1); return ((kk >> 3) * 4 + (c >> 5)) * 512 + ((kk & 7) * 32 + (c & 31)) * 2; }
__device__ __forceinline__ int v_rd_base(int lane) { return ((lane & 3) << 3) | (((lane >> 2) & 3) << 6) | (((lane >> 4) & 1) << 5) | (((lane >> 5) & 1) << 8); }
constexpr int v_rd_off(int d0, int ks, int half) { return d0 * 512 + ks * 4096 + half * 2048; }
template <int OFF> __device__ __forceinline__ s16x4 tr_read(int vb) {
    s16x4 r; asm volatile("ds_read_b64_tr_b16 %0, %1 offset:%2" : "=&v"(r) : "v"(vb), "i"(OFF) : "memory"); return r;
}
template <int D0> __device__ __forceinline__ void pv_one(f32x16& od, int vb, bf16x8 pa0, bf16x8 pa1, bf16x8 pa2, bf16x8 pa3) {
    const s16x4 l0 = tr_read<v_rd_off(D0, 0, 0)>(vb), h0 = tr_read<v_rd_off(D0, 0, 1)>(vb), l1 = tr_read<v_rd_off(D0, 1, 0)>(vb), h1 = tr_read<v_rd_off(D0, 1, 1)>(vb);
    const s16x4 l2 = tr_read<v_rd_off(D0, 2, 0)>(vb), h2 = tr_read<v_rd_off(D0, 2, 1)>(vb), l3 = tr_read<v_rd_off(D0, 3, 0)>(vb), h3 = tr_read<v_rd_off(D0, 3, 1)>(vb);
    asm volatile("s_waitcnt lgkmcnt(0)" ::: "memory"); SBAR();
#define PK(L, H) (bf16x8){L[0], L[1], L[2], L[3], H[0], H[1], H[2], H[3]}
    od = __builtin_amdgcn_mfma_f32_32x32x16_bf16(pa0, PK(l0, h0), od, 0, 0, 0);
    od = __builtin_amdgcn_mfma_f32_32x32x16_bf16(pa1, PK(l1, h1), od, 0, 0, 0);
    od = __builtin_amdgcn_mfma_f32_32x32x16_bf16(pa2, PK(l2, h2), od, 0, 0, 0);
    od = __builtin_amdgcn_mfma_f32_32x32x16_bf16(pa3, PK(l3, h3), od, 0, 0, 0);
#undef PK
}
__device__ __forceinline__ void pv_d0(f32x16* o, int vb, bf16x8 pa0, bf16x8 pa1, bf16x8 pa2, bf16x8 pa3) {
    pv_one<0>(o[0], vb, pa0, pa1, pa2, pa3); pv_one<1>(o[1], vb, pa0, pa1, pa2, pa3); pv_one<2>(o[2], vb, pa0, pa1, pa2, pa3); pv_one<3>(o[3], vb, pa0, pa1, pa2, pa3);
}
template <int DH, int LDK>
__device__ __forceinline__ void body(const bf16_t* __restrict__ Qw, const bf16_t* __restrict__ Kh, const bf16_t* __restrict__ Vh, int seq, int koff, float C, char* lds, f32x16 (&o)[4]) {
    int tid = threadIdx.x; asm volatile("" : "+v"(tid));
    const int wid = tid >> 6, lane = tid & 63, r32 = lane & 31, hi = lane >> 5;
    char* V_lds = lds; char* K_lds = lds + 2 * SHM_V;
    float* ws = (float*)(lds + 2 * SHM_V + 2 * SHM_K) + wid * 64; float* li_l = ws; float* al_l = ws + 32;
    float m_reg = -1e30f, l_reg = 0; bf16x8 qr[DH];
    const float thr = THR * 1.4426950408889634f / C;
#pragma unroll
    for (int d = 0; d < 4; ++d) o[d] = f32x16{};
#pragma unroll
    for (int d0 = 0; d0 < DH; ++d0) qr[d0] = *reinterpret_cast<const bf16x8*>(Qw + d0 * 16);
    const int sr = tid >> 4, sc = (tid & 15) * 8, vst0 = v_st(sr, sc), vst1 = v_st(32 + sr, sc);
    const int vb0 = (int)(uintptr_t)V_lds + v_rd_base(lane);
    struct { bf16x8 vs0, vs1, ks0, ks1; } sr_[2];
#define SLOAD(i, k0) do { sr_[i].vs0 = *(const bf16x8*)(&Vh[(long)((k0) + sr) * LDK + sc]); sr_[i].vs1 = *(const bf16x8*)(&Vh[(long)((k0) + 32 + sr) * LDK + sc]); \
    sr_[i].ks0 = *(const bf16x8*)(&Kh[(long)((k0) + sr) * LDK + sc]); sr_[i].ks1 = *(const bf16x8*)(&Kh[(long)((k0) + 32 + sr) * LDK + sc]); } while (0)
#define SWRITE(b, i) do { *(bf16x8*)(V_lds + (b) * SHM_V + vst0) = sr_[i].vs0;          \
    *(bf16x8*)(V_lds + (b) * SHM_V + vst1) = sr_[i].vs1; const int kc = sc * 2;               \
    *(bf16x8*)(K_lds + (b) * SHM_K + KSWZ(sr, kc)) = sr_[i].ks0;                       \
    *(bf16x8*)(K_lds + (b) * SHM_K + KSWZ(32 + sr, kc)) = sr_[i].ks1; } while (0)
#define SWAIT() asm volatile("s_waitcnt vmcnt(4)" ::: "memory")
#define RESC(a) do { if (__any((a) < 1.f)) { if (hi == 0) al_l[r32] = (a); asm volatile("s_waitcnt lgkmcnt(0)" ::: "memory"); \
    _Pragma("unroll") for (int d = 0; d < 4; ++d) _Pragma("unroll") for (int r = 0; r < 16; ++r) o[d][r] *= al_l[crow(r, hi)]; } } while (0)
    f32x16 pA0, pA1, pB0, pB1; float mnA, mnB, alA, alB; bf16x8 pa0, pa1, pa2, pa3; const int NT = seq / KVBLK;
    constexpr int SE = 0, SO = 1;
    SLOAD(SE, 0); asm volatile("s_waitcnt vmcnt(0)" ::: "memory"); SWRITE(0, SE); __syncthreads();
    qkt<DH>(pA0, pA1, K_lds, qr, r32, hi, koff); partialSM(pA0, pA1, m_reg, mnA, alA, C, thr);
    SLOAD(SO, KVBLK); if (2 < NT) SLOAD(SE, 2 * KVBLK);
    SWAIT(); SWRITE(1, SO); __syncthreads();
    for (int j = 1; j + 1 < NT; j += 2) {
        SBAR(); qkt<DH>(pB0, pB1, K_lds + SHM_K, qr, r32, hi, koff);
        finishSM(pA0, pA1, alA, l_reg, pa0, pa1, pa2, pa3); SBAR();
        SLOAD(SO, (j + 2) * KVBLK); SBAR();
        pv_d0(o, vb0, pa0, pa1, pa2, pa3); partialSM(pB0, pB1, m_reg, mnB, alB, C, thr);
        __syncthreads(); SWAIT(); SWRITE(0, SE);
        RESC(alB); __syncthreads();
        SBAR(); qkt<DH>(pA0, pA1, K_lds, qr, r32, hi, koff);
        finishSM(pB0, pB1, alB, l_reg, pa0, pa1, pa2, pa3); SBAR();
        if (j + 3 < NT) SLOAD(SE, (j + 3) * KVBLK); SBAR();
        pv_d0(o, vb0 + (int)SHM_V, pa0, pa1, pa2, pa3); partialSM(pA0, pA1, m_reg, mnA, alA, C, thr);
        __syncthreads(); SWAIT(); SWRITE(1, SO);
        RESC(alA); __syncthreads();
    }
    SBAR(); qkt<DH>(pB0, pB1, K_lds + SHM_K, qr, r32, hi, koff);
    finishSM(pA0, pA1, alA, l_reg, pa0, pa1, pa2, pa3); SBAR();
    pv_d0(o, vb0, pa0, pa1, pa2, pa3); partialSM(pB0, pB1, m_reg, mnB, alB, C, thr);
    __syncthreads(); RESC(alB);
    finishSM(pB0, pB1, alB, l_reg, pa0, pa1, pa2, pa3); SBAR();
    pv_d0(o, vb0 + (int)SHM_V, pa0, pa1, pa2, pa3);
    if (hi == 0) li_l[r32] = l_reg; asm volatile("s_waitcnt lgkmcnt(0)" ::: "memory");
#pragma unroll
    for (int r = 0; r < 16; ++r) { const float rl = __builtin_amdgcn_rcpf(li_l[crow(r, hi)]);
#pragma unroll
        for (int d = 0; d < 4; ++d) o[d][r] *= rl; }
#undef SLOAD
#undef SWRITE
#undef SWAIT
#undef RESC
}
}

__device__ __forceinline__ void transpose_item(const float* W, int K, int N, bf16_t* WT, int row0, int k0, int srccol4, LAS float* scr, int lane) {
    const int r = lane >> 3, c4 = lane & 7;
    f32x4 v[8];
#pragma unroll
    for (int i = 0; i < 8; ++i) v[i] = *(const f32x4*)(W + (size_t)(k0 + 8 * i + r) * N + srccol4);
#pragma unroll
    for (int i = 0; i < 8; ++i) { LAS float* d = scr + (8 * i + r) * 33 + 4 * c4; d[0] = v[i][0]; d[1] = v[i][1]; d[2] = v[i][2]; d[3] = v[i][3]; }
    LDS_WAIT(); asm volatile("" ::: "memory");
    const int c = lane & 7;
#pragma unroll
    for (int j = 0; j < 4; ++j) { const int n = (lane >> 3) + 8 * j; const LAS float* sp = scr + (8 * c) * 33 + n;
        u32x4 o; o.x = cvt_pk_bf16(sp[0 * 33], sp[1 * 33]); o.y = cvt_pk_bf16(sp[2 * 33], sp[3 * 33]); o.z = cvt_pk_bf16(sp[4 * 33], sp[5 * 33]); o.w = cvt_pk_bf16(sp[6 * 33], sp[7 * 33]);
        *(u32x4*)(WT + blk(row0 + n, k0 + 8 * c, K >> 6)) = o; }
    LDS_WAIT(); asm volatile("" ::: "memory");
}

#define XB_TMO      128
#define XB_XCNT(j)  (256  + 64 * (j))
#define XB_XSUB(j)  (1280 + 64 * (j))
#define XB_XGEN(j)  (2304 + 64 * (j))
#define XB_TOP      3328
#define XB_TOPGEN   3392
#define XCD_BAR_WORDS 3456
#define XB_SPIN_CAP (1u << 18)
__device__ __forceinline__ unsigned xb_ld(unsigned* p)              { return __hip_atomic_load(p, __ATOMIC_RELAXED, __HIP_MEMORY_SCOPE_AGENT); }
__device__ __forceinline__ unsigned xb_add(unsigned* p, unsigned v) { return __hip_atomic_fetch_add(p, v, __ATOMIC_RELAXED, __HIP_MEMORY_SCOPE_AGENT); }
__device__ __forceinline__ unsigned xb_xcc_id() { return (unsigned)__builtin_amdgcn_s_getreg((3 << 11) | 20) & 0xFu; }
#define XB_SPIN(cond, bar) do { unsigned _sp = 0; while (cond) { __builtin_amdgcn_s_sleep(1); \
    if ((++_sp & 255u) == 0u) { if (xb_ld(&(bar)[XB_TMO])) break; if (_sp > XB_SPIN_CAP) { atomicAdd(&(bar)[XB_TMO], 1u); break; } } } } while (0)
struct XcdBarrier { unsigned* bar; unsigned x; volatile LAS unsigned* st; };
__device__ __forceinline__ XcdBarrier xcd_barrier_post(unsigned* bar, volatile LAS unsigned* st) {
    XcdBarrier b; b.bar = bar; b.x = xb_xcc_id(); b.st = st;
    if (threadIdx.x == 0) (void)xb_add(&bar[XB_XCNT(b.x)], 1u);
    return b;
}
__device__ __forceinline__ void xcd_barrier_complete(unsigned* bar, unsigned x, unsigned& nloc, unsigned& nx) {
    const unsigned G = gridDim.x * gridDim.y * gridDim.z;
    unsigned sum, cnt, mine, sp = 0u;
    for (;;) {
        sum = 0u; cnt = 0u; mine = 0u;
#pragma unroll
        for (unsigned j = 0; j < 16; ++j) { const unsigned c = xb_ld(&bar[XB_XCNT(j)]); sum += c; cnt += (c > 0u) ? 1u : 0u; mine = (j == x) ? c : mine; }
        if (sum == G) break;
        __builtin_amdgcn_s_sleep(1);
        if ((++sp & 255u) == 0u) { if (xb_ld(&bar[XB_TMO])) break; if (sp > XB_SPIN_CAP) { atomicAdd(&bar[XB_TMO], 1u); break; } }
    }
    nloc = mine > 0u ? mine : 1u; nx = cnt > 0u ? cnt : 1u;
}
__device__ __forceinline__ void xcd_barrier(const XcdBarrier& b) {
    asm volatile("s_waitcnt vmcnt(0)" ::: "memory");
    __syncthreads();
    if (threadIdx.x == 0) {
        unsigned* bar = b.bar;
        __builtin_amdgcn_s_waitcnt(0);
        unsigned nloc = b.st[0], nx = b.st[1];
        if (nloc == 0u) { xcd_barrier_complete(bar, b.x, nloc, nx); b.st[0] = nloc; b.st[1] = nx; }
        const unsigned old = xb_add(&bar[XB_XSUB(b.x)], 1u);
        const unsigned gen = old / nloc;
        if (old + 1u == (gen + 1u) * nloc) {
            __builtin_amdgcn_fence(__ATOMIC_RELEASE, "agent");
            asm volatile("s_waitcnt vmcnt(0)" ::: "memory");
            const unsigned og = xb_add(&bar[XB_TOP], 1u);
            const unsigned tg = og / nx;
            if (og + 1u == (tg + 1u) * nx) xb_add(&bar[XB_TOPGEN], 1u);
            else XB_SPIN(xb_ld(&bar[XB_TOPGEN]) == tg, bar);
            __builtin_amdgcn_fence(__ATOMIC_ACQUIRE, "agent");
            xb_add(&bar[XB_XGEN(b.x)], 1u);
            asm volatile("s_waitcnt vmcnt(0)" ::: "memory");
        } else {
            XB_SPIN(xb_ld(&bar[XB_XGEN(b.x)]) == gen, bar);
            __builtin_amdgcn_fence(__ATOMIC_ACQUIRE, "agent");
            asm volatile("s_waitcnt vmcnt(0)" ::: "memory");
        }
    }
    __syncthreads();
}

__global__ void __launch_bounds__(512, 2) fwd_megakernel(Params p) {
    extern __shared__ __attribute__((aligned(16))) unsigned char lds_raw[];
    cg::grid_group grid = cg::this_grid();
    LAS unsigned char* lds = (LAS unsigned char*)lds_raw;
    const int G = gridDim.x, bid = blockIdx.x;
    const int NGW = G * 8; const long NGT = (long)G * 512;
    unsigned char* const ws0 = p.ws; float* const out0 = p.out;
    { volatile LAS unsigned* st0 = (volatile LAS unsigned*)(lds + LDSX_OFF + 12288 + 64); if (threadIdx.x < 2) st0[threadIdx.x] = 0u; }
    __syncthreads();
    {
        constexpr long NZ = (long)(WS_BAR + 16384) / 16;
        for (long i = (long)blockIdx.x * 512 + threadIdx.x; i < NZ; i += (long)gridDim.x * 512) *(u32x4*)(ws0 + WS_CTL + i * 16) = (u32x4){0u, 0u, 0u, 0u};
    }
#define GSYNC() do { XcdBarrier xb_; xb_.bar = (unsigned*)(opaque(ws0) + WS_BAR); xb_.x = xb_xcc_id(); xb_.st = (volatile LAS unsigned*)(lds + LDSX_OFF + 12288 + 64); xcd_barrier(xb_); } while (0)
#define TIDS() int tid = threadIdx.x; asm volatile("" : "+v"(tid)); const int lane = tid & 63, wave = __builtin_amdgcn_readfirstlane(tid >> 6); const int gw = bid * 8 + wave; const long gtid = (long)bid * 512 + tid; (void)lane; (void)gw; (void)gtid;

    if (bid < 192) { TIDS();
        const float* cvec = p.in[6]; const float* c_ctx = p.in[7]; const float* w_ada = p.in[10]; const float* b_ada = p.in[11];
        float* MOD = (float*)(ws0 + WS_MOD);
        LAS float* sl = (LAS float*)lds;
        LAS float* red = (LAS float*)(lds + 40960);
        for (int i = tid; i < 5 * DM; i += 512) { const int cnd = i / DM, k = i % DM; const float v = cnd == 0 ? c_ctx[k] : cvec[(cnd - 1) * DM + k]; sl[i] = silu_f(v); }
        __syncthreads();
        const int l = bid / 96, cgp = bid % 96, tx = tid & 31, ky = tid >> 5;
        const float* Wp = w_ada + (size_t)l * DM * 12288 + (size_t)(ky * 128) * 12288 + cgp * 128 + 4 * tx;
        f32x4 a[5];
#pragma unroll
        for (int c = 0; c < 5; ++c) a[c] = (f32x4){0.f, 0.f, 0.f, 0.f};
#pragma unroll 8
        for (int k = 0; k < 128; ++k) { const f32x4 wv = *(const f32x4*)(Wp + (size_t)k * 12288);
#pragma unroll
            for (int c = 0; c < 5; ++c) a[c] += wv * sl[c * DM + ky * 128 + k]; }
#pragma unroll
        for (int c = 0; c < 5; ++c) *(LAS f32x4*)(red + (ky * 5 + c) * 128 + 4 * tx) = a[c];
        __syncthreads();
        for (int i = tid; i < 640; i += 512) { const int c = i >> 7, col = i & 127; float sm = 0.f;
#pragma unroll
            for (int k = 0; k < 16; ++k) sm += red[(k * 5 + c) * 128 + col];
            MOD[(size_t)(l * 5 + c) * 12288 + cgp * 128 + col] = sm + b_ada[l * 12288 + cgp * 128 + col]; }
        __syncthreads();
    }
    {
        TIDS();
        const float* w_in = p.in[12]; const float* w_out = p.in[20]; const float* w_gate = p.in[21]; const float* w_up = p.in[22]; const float* w_down = p.in[25];
        bf16_t* WIN = (bf16_t*)(ws0 + WS_WIN); bf16_t* WOUT = (bf16_t*)(ws0 + WS_WOUT); bf16_t* WGU = (bf16_t*)(ws0 + WS_WGU); bf16_t* WDN = (bf16_t*)(ws0 + WS_WDN);
        LAS float* scr = (LAS float*)(lds + wave * 16384);
        constexpr int I_IN = 32 * 96, I_OUT = 32 * 64, I_GU = 32 * 352, I_DN = 88 * 64, I_L = I_IN + I_OUT + I_GU + I_DN;
        const int nfree = (G > 192) ? (G - 192) * 8 : 0, XA_ = nfree * 20 < 2 * I_L ? nfree * 20 : 0;
        for (int stg = 0; stg < 2; ++stg) {
        const int it0_ = stg == 0 ? (bid >= 192 ? (bid - 192) * 8 + wave : 2 * I_L) : XA_ + gw, step_ = stg == 0 ? (nfree > 0 ? nfree : 1) : NGW, lim_ = stg == 0 ? XA_ : 2 * I_L;
        for (int it = it0_; it < lim_; it += step_) {
            const int l = it / I_L; int r = it % I_L;
            if (r < I_IN) { const int kb = r / 96, nb = r % 96; const int L = nb * 32 + 4 * (lane & 7);
                transpose_item(w_in + (size_t)l * DM * DIN, DM, DIN, WIN + (size_t)l * NIN * DM, nb * 32, kb * 64, win_srccol(L), scr, lane); continue; }
            r -= I_IN;
            if (r < I_OUT) { const int kb = r / 64, nb = r % 64;
                transpose_item(w_out + (size_t)l * DM * DM, DM, DM, WOUT + (size_t)l * DM * DM, nb * 32, kb * 64, nb * 32 + 4 * (lane & 7), scr, lane); continue; }
            r -= I_OUT;
            if (r < I_GU) { const int kb = r / 352, nb = r % 352; const int L0 = nb * 32, pn = L0 >> 8, bj = (L0 >> 7) & 1, lam0 = L0 & 127;
                transpose_item((bj ? w_up : w_gate) + (size_t)l * DM * DFF, DM, DFF, WGU + (size_t)l * NGU * DM, L0, kb * 64, pn * 128 + lam0 + 4 * (lane & 7), scr, lane); continue; }
            r -= I_GU;
            { const int kb = r / 64, nb = r % 64;
                transpose_item(w_down + (size_t)l * DFF * DM, DFF, DM, WDN + (size_t)l * DM * DFF, nb * 32, kb * 64, nb * 32 + 4 * (lane & 7), scr, lane); }
        }
        }
        LAS float* trg = scr + 16 * 128;
        for (int j = lane; j < 128; j += 64) { trg[j] = __builtin_amdgcn_cosf((float)j * (1.f / 128.f)); trg[128 + j] = __builtin_amdgcn_sinf((float)j * (1.f / 128.f)); }
        LDS_WAIT();
        for (int it = gw; it < 2 * 2 * 4 * 128 * 4; it += NGW) {
            const int mb = it & 3, kb = (it >> 2) & 127, g = (it >> 9) & 3, cs = (it >> 11) & 1, l = it >> 12;
            const float* Wl = w_in + (size_t)l * DM * DIN + 3072 + g * 128;
#pragma unroll
            for (int i = 0; i < 8; ++i) { const int kk = 2 * i + (lane >> 5);
                *(LAS f32x4*)(scr + kk * 128 + 4 * (lane & 31)) = *(const f32x4*)(Wl + (size_t)(kb * 16 + kk) * DIN + 4 * (lane & 31)); }
            LDS_WAIT(); asm volatile("" ::: "memory");
            const int m = mb * 32 + (lane & 31), kh = lane >> 5;
            float a8[8];
#pragma unroll
            for (int i = 0; i < 8; ++i) a8[i] = 0.f;
            const LAS float* tt = trg + cs * 128;
            for (int c = 0; c < 128; ++c) { const float tv = tt[(c * m) & 127];
#pragma unroll
                for (int i = 0; i < 8; ++i) a8[i] += scr[(kh * 8 + i) * 128 + c] * tv; }
            u32x4 o; o.x = cvt_pk_bf16(a8[0], a8[1]); o.y = cvt_pk_bf16(a8[2], a8[3]); o.z = cvt_pk_bf16(a8[4], a8[5]); o.w = cvt_pk_bf16(a8[6], a8[7]);
            *(u32x4*)(WIN + (size_t)l * NIN * DM + blk(3072 + cs * 512 + g * 128 + m, kb * 16 + kh * 8, 32)) = o;
            LDS_WAIT(); asm volatile("" ::: "memory");
        }
    }
    {
        TIDS();
        bf16_t* DFTC = (bf16_t*)(ws0 + WS_DFTC); bf16_t* DFTL = (bf16_t*)(ws0 + WS_DFTL); float* ROPE = (float*)(ws0 + WS_ROPE); float* LAM = (float*)(ws0 + WS_LAM);
        const float scl = 1.f / sqrtf(4096.f * 128.f);
        for (long i = gtid; i < 512L * 512 / 8; i += NGT) { const int R = (int)(i >> 6), c8 = (int)(i & 63) * 8, cs = c8 >> 8, n0 = c8 & 255;
            const int im = (R >> 7) & 1, k1 = (R >> 8) * 128 + (R & 127);
            float v[8];
#pragma unroll
            for (int j = 0; j < 8; ++j) { const float ph = (float)((k1 * (n0 + j)) & 255) * (1.f / 256.f);
                const float c = __builtin_amdgcn_cosf(ph), sn = __builtin_amdgcn_sinf(ph);
                v[j] = (im == 0 ? (cs == 0 ? c : -sn) : (cs == 0 ? -sn : -c)) * scl; }
            u32x4 o; o.x = cvt_pk_bf16(v[0], v[1]); o.y = cvt_pk_bf16(v[2], v[3]); o.z = cvt_pk_bf16(v[4], v[5]); o.w = cvt_pk_bf16(v[6], v[7]);
            *(u32x4*)(DFTL + i * 8) = o; }
        const float scc = 1.f / sqrtf(256.f * 128.f);
        for (long i = gtid; i < 256L * 512 / 8; i += NGT) { const int k = (int)(i >> 6), c8 = (int)(i & 63) * 8, cs = c8 >> 8, n0 = c8 & 255;
            float v[8];
#pragma unroll
            for (int j = 0; j < 8; ++j) { const float ph = (float)((k * (n0 + j)) & 255) * (1.f / 256.f); v[j] = (cs ? -__builtin_amdgcn_sinf(ph) : __builtin_amdgcn_cosf(ph)) * scc; }
            u32x4 o; o.x = cvt_pk_bf16(v[0], v[1]); o.y = cvt_pk_bf16(v[2], v[3]); o.z = cvt_pk_bf16(v[4], v[5]); o.w = cvt_pk_bf16(v[6], v[7]);
            *(u32x4*)(DFTC + i * 8) = o; }
        for (long i = gtid; i < 2048 + 1024; i += NGT) {
            if (i < 2048) { const int pos = (int)i >> 5, j = (int)i & 31; const float ang = (float)pos * powf(10000.f, -(float)j / 32.f); ROPE[i] = cosf(ang); ROPE[2048 + i] = sinf(ang); }
            else { const int ii = (int)i - 2048, pos = ii >> 4, j = ii & 15; const float ang = (float)pos * powf(10000.f, -(float)j / 16.f); ROPE[4096 + ii] = cosf(ang); ROPE[5120 + ii] = sinf(ang); }
        }
        if (gtid < 2) { const int l = (int)gtid; float s1 = 0.f, s2 = 0.f;
            const float* lq1 = p.in[15]; const float* lk1 = p.in[16]; const float* lq2 = p.in[17]; const float* lk2 = p.in[18];
            for (int j = 0; j < 64; ++j) { s1 += lq1[l * 64 + j] * lk1[l * 64 + j]; s2 += lq2[l * 64 + j] * lk2[l * 64 + j]; }
            LAM[l] = expf(s1) - expf(s2) + (0.8f - 0.6f * expf(-0.3f * (float)l)); }
        float* SP = (float*)(ws0 + WS_SMALL);
        for (long i = gtid; i < SP_END; i += NGT) { const int j = (int)i; float v;
            if (j < SP_N2) v = p.in[8][j - SP_N1]; else if (j < SP_QN) v = p.in[9][j - SP_N2]; else if (j < SP_KN) v = p.in[13][j - SP_QN];
            else if (j < SP_SUB) v = p.in[14][j - SP_KN]; else if (j < SP_FIN) v = p.in[19][j - SP_SUB]; else if (j < SP_CB) v = p.in[26][j - SP_FIN];
            else if (j < SP_CW) v = p.in[24][j - SP_CB]; else v = p.in[23][j - SP_CW];
            SP[j] = v; }
        bf16_t* CST = (bf16_t*)(ws0 + WS_CST);
        for (int r = gw; r < 2048; r += NGW) {
            const int l = r >> 10, b = (r >> 8) & 3, j = r & 255; const size_t cro = (size_t)((b * 2 + l) * 256 + j);
            bf16_t* dst = CST + (size_t)r * 1536;
            { const int L = lane * 4; const int sc_ = win_srccol(L);
              const f32x4 v = *(const f32x4*)(p.in[2] + cro * 256 + sc_); u32x2 wv; wv.x = cvt_pk_bf16(v[0], v[1]); wv.y = cvt_pk_bf16(v[2], v[3]); *(u32x2*)(dst + L) = wv;
              const f32x4 v2 = *(const f32x4*)(p.in[3] + cro * 256 + L); u32x2 w2; w2.x = cvt_pk_bf16(v2[0], v2[1]); w2.y = cvt_pk_bf16(v2[2], v2[3]); *(u32x2*)(dst + 256 + L) = w2; }
#pragma unroll
            for (int h2 = 0; h2 < 2; ++h2) { const int L = h2 * 256 + lane * 4; const int sc_ = win_srccol(2048 + L) - 2048;
              const f32x4 v = *(const f32x4*)(p.in[4] + cro * 512 + sc_); u32x2 wv; wv.x = cvt_pk_bf16(v[0], v[1]); wv.y = cvt_pk_bf16(v[2], v[3]); *(u32x2*)(dst + 512 + L) = wv;
              const f32x4 v2 = *(const f32x4*)(p.in[5] + cro * 512 + L); u32x2 w2; w2.x = cvt_pk_bf16(v2[0], v2[1]); w2.y = cvt_pk_bf16(v2[2], v2[3]); *(u32x2*)(dst + 1024 + L) = w2; }
        }
    }
    grid.sync();
    (void)xcd_barrier_post((unsigned*)(ws0 + WS_BAR), (volatile LAS unsigned*)(lds + LDSX_OFF + 12288 + 64));
    {
        TIDS();
        const float* x_prompt = p.in[0]; const float* x_sample = p.in[1]; const float* norm1_g = p.in[8];
        const float* MOD = (const float*)(ws0 + WS_MOD); float* SS = (float*)(ws0 + WS_SS); bf16_t* XA = (bf16_t*)(ws0 + WS_XA);
        for (int row0 = gw; row0 < T; row0 += 2 * NGW) {
            f32x4 xv[2][4][2]; int rows[2]; bool live[2];
#pragma unroll
            for (int u = 0; u < 2; ++u) { const int row = row0 + u * NGW; rows[u] = row; live[u] = row < T;
                const int rr = live[u] ? row : row0;
                const float* xr = rr < NCTX ? x_prompt + (size_t)rr * DM : x_sample + (size_t)(rr - NCTX) * DM;
#pragma unroll
                for (int j = 0; j < 4; ++j) { const int c = j * 512 + lane * 8; xv[u][j][0] = *(const f32x4*)(xr + c); xv[u][j][1] = *(const f32x4*)(xr + c + 4); } }
#pragma unroll
            for (int u = 0; u < 2; ++u) { const int row = live[u] ? rows[u] : row0;
                const int cond = row < NCTX ? 0 : 1 + ((row - NCTX) >> 12);
                const float* sc = MOD + (size_t)(0 * 5 + cond) * 12288 + 1 * DM;
                float sm = 0.f;
#pragma unroll
                for (int j = 0; j < 4; ++j) { const int c = j * 512 + lane * 8; const f32x4 x0 = xv[u][j][0], x1 = xv[u][j][1];
                    const f32x4 g0 = *(const f32x4*)(norm1_g + c) * (*(const f32x4*)(sc + c) + 1.f), g1 = *(const f32x4*)(norm1_g + c + 4) * (*(const f32x4*)(sc + c + 4) + 1.f);
                    sm += (x0[0] * x0[0] + x0[1] * x0[1]) + (x0[2] * x0[2] + x0[3] * x0[3]) + (x1[0] * x1[0] + x1[1] * x1[1]) + (x1[2] * x1[2] + x1[3] * x1[3]);
                    if (live[u]) *(u32x4*)(XA + blk(row, c, 32)) = pack8(x0 * g0, x1 * g1); }
                sm = wave_sum(sm);
                if (lane == 0 && live[u]) SS[row] = sm; }
        }
        const bf16_t* WIN = (const bf16_t*)(ws0 + WS_WIN); const bf16_t* WGU = (const bf16_t*)(ws0 + WS_WGU);
        float* BIASIN = (float*)(ws0 + WS_BIASIN); float* BIASGU = (float*)(ws0 + WS_BIASGU);
        for (int it0 = gw; it0 < 2 * (NIN + NGU); it0 += 2 * NGW) {
            u32x4 wv[2][4]; bool live[2];
#pragma unroll
            for (int u = 0; u < 2; ++u) { const int it = it0 + u * NGW; live[u] = it < 2 * (NIN + NGU); const int itt = live[u] ? it : it0;
                const int l = itt / (NIN + NGU), r = itt % (NIN + NGU); const bool isin = r < NIN; const int L = isin ? r : r - NIN;
                const bf16_t* br = isin ? WIN + (size_t)l * NIN * DM : WGU + (size_t)l * NGU * DM;
#pragma unroll
                for (int j = 0; j < 4; ++j) wv[u][j] = *(const u32x4*)(br + blk(L, j * 512 + lane * 8, 32)); }
#pragma unroll
            for (int u = 0; u < 2; ++u) { const int it = live[u] ? it0 + u * NGW : it0;
                const int l = it / (NIN + NGU), r = it % (NIN + NGU); const bool isin = r < NIN; const int L = isin ? r : r - NIN;
                float a[5] = {0.f, 0.f, 0.f, 0.f, 0.f};
#pragma unroll
                for (int j = 0; j < 4; ++j) { const int c = j * 512 + lane * 8; const u32x4 w4 = wv[u][j];
                    float wf[8]; wf[0] = __uint_as_float(w4.x << 16); wf[1] = __uint_as_float(w4.x & 0xffff0000u); wf[2] = __uint_as_float(w4.y << 16); wf[3] = __uint_as_float(w4.y & 0xffff0000u);
                    wf[4] = __uint_as_float(w4.z << 16); wf[5] = __uint_as_float(w4.z & 0xffff0000u); wf[6] = __uint_as_float(w4.w << 16); wf[7] = __uint_as_float(w4.w & 0xffff0000u);
#pragma unroll
                    for (int cnd = 0; cnd < 5; ++cnd) { const float* sh = MOD + (size_t)(l * 5 + cnd) * 12288 + (isin ? 0 : 3 * DM) + c;
                        const f32x4 s0 = *(const f32x4*)sh, s1 = *(const f32x4*)(sh + 4);
                        a[cnd] += (wf[0] * s0[0] + wf[1] * s0[1]) + (wf[2] * s0[2] + wf[3] * s0[3]) + (wf[4] * s1[0] + wf[5] * s1[1]) + (wf[6] * s1[2] + wf[7] * s1[3]); } }
#pragma unroll
                for (int cnd = 0; cnd < 5; ++cnd) { const float sm = wave_sum(a[cnd]);
                    if (lane == 0 && live[u]) { if (isin) BIASIN[(size_t)(l * 5 + cnd) * NIN + L] = sm; else BIASGU[(size_t)(l * 5 + cnd) * NGU + L] = sm; } } }
        }
    }
    GSYNC();

    for (int l = 0; l < 2; ++l) {
        {
            TIDS();
            unsigned char* w = opaque(ws0);
            const bf16_t* CST = (const bf16_t*)(w + WS_CST) + (size_t)l * 1024 * 1536;
            for (int r = gw; r < 1024; r += NGW) {
                const int b = r >> 8, j = r & 255; const size_t kr = (size_t)(NCTX + b * 4352 + j);
#pragma unroll
                for (int t3 = 0; t3 < 3; ++t3) { const int c = t3 * 64 + lane; const u32x4 v = *(const u32x4*)(CST + (size_t)r * 1536 + c * 8);
                    bf16_t* d;
                    if (c < 32) d = (bf16_t*)(w + WS_KA) + kr * 256 + c * 8; else if (c < 64) d = (bf16_t*)(w + WS_VA) + kr * 256 + (c - 32) * 8;
                    else if (c < 128) d = (bf16_t*)(w + WS_KB) + kr * 512 + (c - 64) * 8; else d = (bf16_t*)(w + WS_VB) + kr * 512 + (c - 128) * 8;
                    *(u32x4*)d = v; }
            }
            pg8::Gemm g{(const bf16_t*)(w + WS_XA), (const bf16_t*)(w + WS_WIN) + (size_t)l * NIN * DM, T, NIN, DM}; pg8::StaticOrder S; S.init(T, NIN, G, bid);
            EpiIn E{ws0, out0, l};
            pg8::gemm_phase<EpiIn, pg8::StaticOrder, true, true>(lds, g, S, E);
        }
        GSYNC();
        {
            { unsigned char* w = opaque(ws0);
              pg8::Gemm g{(const bf16_t*)(w + WS_DFTL), (const bf16_t*)(w + WS_FTL), 512, 32768, 512}; pg8::StridedUnits S{bid, G, 256}; EpiFft E{ws0};
              pg8::gemm_phase<EpiFft, pg8::StridedUnits>(lds, g, S, E); }
            { unsigned char* w = opaque(ws0);
              pg8::Gemm g{(const bf16_t*)(w + WS_DFTC), (const bf16_t*)(w + WS_FTC), 256, 16384, 512}; pg8::OneUnit S{bid < 64 ? 1 : 0, 0, bid}; EpiDft E{ws0, 0};
              pg8::gemm_phase<EpiDft, pg8::OneUnit>(lds, g, S, E); }
            __syncthreads();
            LAS unsigned* slot = (LAS unsigned*)(lds + LDSX_OFF + 12288);
            char* attl = (char*)lds_raw;
            for (;;) {
                TIDS();
                const int r32 = lane & 31, hi = lane >> 5;
                unsigned char* w = opaque(ws0);
                if (tid == 0) *slot = atomicAdd((unsigned*)(w + WS_CNT) + 64 * l, 1u);
                __syncthreads();
                const int q = (int)*slot;
                __syncthreads();
                if (q >= 1536) break;
                bf16_t* MIX = (bf16_t*)(w + WS_MIX);
                f32x16 o[4];
                if (q < 512 || (q >= 1024 && q < 1280)) {
                    int tok0, kr0, h, seq;
                    if (q < 512) { const int b = q >> 7; h = (q >> 4) & 7; const int qb = q & 15; tok0 = NCTX + b * 4096 + qb * 256; kr0 = NCTX + b * 4352; seq = 4352; }
                    else { const int qq = q - 1024, b = qq >> 3; h = qq & 7; tok0 = b * 256; kr0 = b * 256; seq = 256; }
                    const bf16_t* Qw = (const bf16_t*)(w + WS_QA) + (size_t)(tok0 + wave * 32 + r32) * 1024 + h * 128 + hi * 8;
                    att::body<8, 256>(Qw, (const bf16_t*)(w + WS_KA) + (size_t)kr0 * 256 + (h >> 2) * 128, (const bf16_t*)(w + WS_VA) + (size_t)kr0 * 256 + (h >> 2) * 128, seq, 0,
                                      0.08838834764831845f * 1.4426950408889634f, attl, o);
#pragma unroll
                    for (int r = 0; r < 16; ++r) { const int orow = tok0 + wave * 32 + att::crow(r, hi);
#pragma unroll
                        for (int d0 = 0; d0 < 4; ++d0) MIX[(size_t)orow * DM + h * 128 + d0 * 32 + r32] = (bf16_t)(cvt_pk_bf16(o[d0][r], 0.f) & 0xffff); }
                } else {
                    int tok0, kr0, hb, seq;
                    if (q < 1024) { const int qq = q - 512, b = qq >> 7; hb = (qq >> 5) & 3; const int qb = qq & 31; tok0 = NCTX + b * 4096 + qb * 128; kr0 = NCTX + b * 4352; seq = 4352; }
                    else { const int qq = q - 1280, b = qq >> 3; hb = (qq >> 1) & 3; const int qb = qq & 1; tok0 = b * 256 + qb * 128; kr0 = b * 256; seq = 256; }
                    const int br = wave >> 2, ws4 = wave & 3;
                    const bf16_t* Qw = (const bf16_t*)(w + WS_QB) + (size_t)(tok0 + ws4 * 32 + r32) * 512 + hb * 128 + br * 64 + hi * 8;
                    att::body<4, 512>(Qw, (const bf16_t*)(w + WS_KB) + (size_t)kr0 * 512 + hb * 128, (const bf16_t*)(w + WS_VB) + (size_t)kr0 * 512 + hb * 128, seq, br * 128,
                                      0.125f * 1.4426950408889634f, attl, o);
                    __syncthreads();
                    LAS float* st = (LAS float*)lds + ws4 * 4096;
                    if (br == 1) {
#pragma unroll
                        for (int d0 = 0; d0 < 4; ++d0)
#pragma unroll
                            for (int r = 0; r < 16; ++r) st[(d0 * 16 + r) * 64 + lane] = o[d0][r];
                    }
                    __syncthreads();
                    if (br == 0) {
                        const float lam = *((const float*)(w + WS_LAM) + l), oml = 1.f - (0.8f - 0.6f * expf(-0.3f * (float)l));
                        float sq[16];
#pragma unroll
                        for (int r = 0; r < 16; ++r) { float sm = 0.f;
#pragma unroll
                            for (int d0 = 0; d0 < 4; ++d0) { const float v = o[d0][r] - lam * st[(d0 * 16 + r) * 64 + lane]; o[d0][r] = v; sm += v * v; }
                            sq[r] = sm; }
#pragma unroll
                        for (int r = 0; r < 16; ++r) { float sm = sq[r];
#pragma unroll
                            for (int off = 1; off < 32; off <<= 1) sm += __shfl_xor(sm, off);
                            sq[r] = rsqrtf(sm * (1.f / 128.f) + EPS) * oml; }
                        const float* sg = (const float*)(w + WS_SMALL) + SP_SUB + l * 128;
                        float gs[4];
#pragma unroll
                        for (int d0 = 0; d0 < 4; ++d0) gs[d0] = sg[d0 * 32 + r32];
#pragma unroll
                        for (int r = 0; r < 16; ++r) { const int orow = tok0 + ws4 * 32 + att::crow(r, hi);
#pragma unroll
                            for (int d0 = 0; d0 < 4; ++d0) MIX[(size_t)orow * DM + 1024 + hb * 128 + d0 * 32 + r32] = (bf16_t)(cvt_pk_bf16(o[d0][r] * sq[r] * gs[d0], 0.f) & 0xffff); }
                    }
                    __syncthreads();
                }
            }
        }
        GSYNC();
        {
            unsigned char* w = opaque(ws0);
            pg8::Gemm g{(const bf16_t*)(w + WS_MIX), (const bf16_t*)(w + WS_WOUT) + (size_t)l * DM * DM, T, DM, DM}; pg8::StaticOrder S; S.init(T, DM, G, bid);
            if (l == 0) { EpiRes<true, false> E{ws0, out0, p.in[0], p.in[1], l * 5 * 12288 + 2 * DM, SP_N2 + l * DM, l * 5 * 12288 + 4 * DM, 2 * l + 1};
                pg8::gemm_phase<EpiRes<true, false>, pg8::StaticOrder, false, true>(lds, g, S, E); }
            else { EpiRes<false, false> E{ws0, out0, nullptr, nullptr, l * 5 * 12288 + 2 * DM, SP_N2 + l * DM, l * 5 * 12288 + 4 * DM, 2 * l + 1};
                pg8::gemm_phase<EpiRes<false, false>, pg8::StaticOrder, false, true>(lds, g, S, E); }
        }
        GSYNC();
        {
            unsigned char* w = opaque(ws0);
            pg8::Gemm g{(const bf16_t*)(w + WS_XA), (const bf16_t*)(w + WS_WGU) + (size_t)l * NGU * DM, T, NGU, DM}; pg8::StaticOrder S; S.init(T, NGU, G, bid);
            EpiGU E{ws0, l};
            pg8::gemm_phase<EpiGU, pg8::StaticOrder, true, true>(lds, g, S, E);
        }
        GSYNC();
        {
            TIDS();
            unsigned char* w = opaque(ws0);
            const float* EDGE = (const float*)(w + WS_EDGE); const float* cw = (const float*)(w + WS_SMALL) + SP_CW + (size_t)l * 3 * DFF; bf16_t* HFF = (bf16_t*)(w + WS_HFF);
            for (long i = gtid; i < 128L * DFF; i += NGT) {
                const int e = (int)(i / DFF), ch = (int)(i % DFF), pml = e >> 1, side = e & 1;
                const bool interior = side == 0 ? ((pml & 15) != 0) : ((pml & 15) != 15);
                if (!interior) continue;
                const float* me = EDGE + (size_t)(e * 3) * DFF;
                const float* ot = EDGE + (size_t)(((side == 0 ? pml - 1 : pml + 1) * 2 + (1 - side)) * 3 + 1) * DFF;
                const float wv = cw[(side == 0 ? 0 : 2) * DFF + ch];
                const float cvv = me[ch] + wv * ot[ch];
                const float h = silu_f(cvv) * me[2 * DFF + ch];
                const int row = NCTX + pml * 256 + (side ? 255 : 0);
                HFF[blk(row, ch, 88)] = (bf16_t)(cvt_pk_bf16(h, 0.f) & 0xffff);
            }
        }
        GSYNC();
        {
            unsigned char* w = opaque(ws0);
            pg8::Gemm g{(const bf16_t*)(w + WS_HFF), (const bf16_t*)(w + WS_WDN) + (size_t)l * DM * DFF, T, DM, DFF}; pg8::StaticOrder S; S.init(T, DM, G, bid);
            if (l == 0) { EpiRes<false, false> E{ws0, out0, nullptr, nullptr, l * 5 * 12288 + 5 * DM, SP_N1 + DM, 5 * 12288 + 1 * DM, 2 * l + 2};
                pg8::gemm_phase<EpiRes<false, false>, pg8::StaticOrder, true, true>(lds, g, S, E); }
            else if (G == 256) { EpiRes<false, true> E{ws0, out0, nullptr, nullptr, l * 5 * 12288 + 5 * DM, SP_FIN, 0, 2 * l + 2}; pg8::PanelOrder SP{bid, G};
                pg8::gemm_phase<EpiRes<false, true>, pg8::PanelOrder, true, true>(lds, g, SP, E); }
            else { EpiRes<false, false, true> E{ws0, out0, nullptr, nullptr, l * 5 * 12288 + 5 * DM, -1, 5 * 12288 + 1 * DM, 2 * l + 2};
                pg8::gemm_phase<EpiRes<false, false, true>, pg8::StaticOrder, true, true>(lds, g, S, E); }
        }
        if (l == 0 || G != 256) GSYNC();
    }
    if (G != 256) {
        TIDS();
        unsigned char* w = opaque(ws0); float* X = opaque(out0);
        const float* SS = (const float*)(w + WS_SS) + (size_t)4 * T; const float* fin_g = (const float*)(w + WS_SMALL) + SP_FIN;
        for (int row = gw; row < T; row += NGW) {
            const float rs = rsqrtf(SS[row] * (1.f / DM) + EPS);
            float* xr = X + (size_t)row * DM;
#pragma unroll
            for (int j = 0; j < 8; ++j) { const int c = j * 256 + lane * 4; const f32x4 x = *(const f32x4*)(xr + c); *(f32x4*)(xr + c) = x * rs * *(const f32x4*)(fin_g + c); }
        }
    }
}

extern "C" void kernel_launch(void* const* d_in, const int* in_sizes, int n_in, void* d_out, int out_size, void* d_ws, size_t ws_size, hipStream_t stream) {
    static int grid_blocks = 0;
    if (grid_blocks == 0) {
        int dev = 0, cus = 0, per_cu = 0;
        if (n_in != 27 || ws_size < WS_END) { fprintf(stderr, "kernel_launch: n_in %d ws %zu (need %zu)\n", n_in, ws_size, (size_t)WS_END); grid_blocks = -1; return; }
        (void)hipGetDevice(&dev);
        (void)hipDeviceGetAttribute(&cus, hipDeviceAttributeMultiprocessorCount, dev);
        (void)hipFuncSetAttribute((const void*)fwd_megakernel, hipFuncAttributeMaxDynamicSharedMemorySize, LDS_BYTES);
        (void)hipOccupancyMaxActiveBlocksPerMultiprocessor(&per_cu, (const void*)fwd_megakernel, 512, LDS_BYTES);
        (void)hipGetLastError();
        grid_blocks = cus > 0 ? cus : 256;
        fprintf(stderr, "kernel_launch: cus %d per_cu %d grid %d ws %zu\n", cus, per_cu, grid_blocks, ws_size);
    }
    if (grid_blocks < 0) return;
    Params p{};
    for (int i = 0; i < 27; ++i) p.in[i] = (const float*)d_in[i];
    p.out = (float*)d_out; p.ws = (unsigned char*)d_ws;
    void* args[] = {&p};
    hipError_t e = hipLaunchCooperativeKernel((const void*)fwd_megakernel, dim3(grid_blocks), dim3(512), args, LDS_BYTES, stream);
    if (e != hipSuccess) fprintf(stderr, "cooperative launch failed: %s (grid %d)\n", hipGetErrorString(e), grid_blocks);
}
```

```cpp
#include <hip/hip_runtime.h>
#include <hip/hip_cooperative_groups.h>
#include <cstdio>
#include <cstdint>
namespace cg = cooperative_groups;

#define LAS __attribute__((address_space(3)))
typedef unsigned short bf16_t;
typedef short bf16x8 __attribute__((ext_vector_type(8)));
typedef short s16x4 __attribute__((ext_vector_type(4)));
typedef float f32x4 __attribute__((ext_vector_type(4)));
typedef float f32x16 __attribute__((ext_vector_type(16)));
typedef unsigned u32x4 __attribute__((ext_vector_type(4)));
typedef unsigned u32x2 __attribute__((ext_vector_type(2)));

constexpr int DM = 2048, NCTX = 8192, NLAT = 16384, T = NCTX + NLAT, DFF = 5632, NGU = 2 * DFF, NIN = 4096, DIN = 3584;
constexpr int KVROWS = NCTX + 4 * 4352;
constexpr float EPS = 1e-6f;
constexpr size_t MiB = 1u << 20;
constexpr size_t WS_CTL = 0;
constexpr size_t CTL_BYTES = 1 * MiB;
constexpr size_t WS_SS = 0;
constexpr size_t WS_CNT = 512 * 1024;
constexpr size_t WS_BAR = 512 * 1024 + 65536;
constexpr size_t WS_MOD = 1 * MiB;
constexpr size_t WS_BIASIN = 2 * MiB;
constexpr size_t WS_BIASGU = 2 * MiB + 512 * 1024;
constexpr size_t WS_ROPE = 3 * MiB;
constexpr size_t WS_LAM = 3 * MiB + 64 * 1024;
constexpr size_t WS_EDGE = 4 * MiB;
constexpr size_t WS_DFTC = 13 * MiB;
constexpr size_t WS_DFTL = 14 * MiB;
constexpr size_t WS_WIN = 78 * MiB;
constexpr size_t WS_WOUT = 110 * MiB;
constexpr size_t WS_WGU = 126 * MiB;
constexpr size_t WS_WDN = 214 * MiB;
constexpr size_t WS_XA = 258 * MiB;
constexpr size_t WS_QA = 354 * MiB;
constexpr size_t WS_QB = 402 * MiB;
constexpr size_t WS_KA = 426 * MiB;
constexpr size_t WS_VA = 439 * MiB;
constexpr size_t WS_KB = 452 * MiB;
constexpr size_t WS_VB = 477 * MiB;
constexpr size_t WS_FTC = 502 * MiB;
constexpr size_t WS_FTL = 518 * MiB;
constexpr size_t WS_MIX = 550 * MiB;
constexpr size_t WS_HFF = 354 * MiB;
constexpr size_t WS_CST = 646 * MiB;
constexpr size_t WS_X16 = 652 * MiB;
constexpr size_t WS_END = 748 * MiB;
constexpr size_t WS_SMALL = 3 * MiB + 128 * 1024;
constexpr int SP_N1 = 0, SP_N2 = 4096, SP_QN = 8192, SP_KN = 8448, SP_SUB = 8704, SP_FIN = 8960, SP_CB = 11008, SP_CW = 22272, SP_END = 56064;
constexpr size_t O_Y = 0, O_K = (size_t)T * DM, O_V = O_K + 4194304, O_DK = O_V + 4194304, O_DV = O_DK + 8388608;
constexpr int RING_BYTES = 131072, LDSX_OFF = 131072, LDS_BYTES = 147456;

struct Params {
    const float* in[27];
    float* out;
    unsigned char* ws;
};

__device__ __forceinline__ unsigned cvt_pk_bf16(float lo, float hi) { unsigned r; asm volatile("v_cvt_pk_bf16_f32 %0, %1, %2" : "=v"(r) : "v"(lo), "v"(hi)); return r; }
__device__ __forceinline__ u32x4 pack8(f32x4 a, f32x4 b) { u32x4 w; w.x = cvt_pk_bf16(a[0], a[1]); w.y = cvt_pk_bf16(a[2], a[3]); w.z = cvt_pk_bf16(b[0], b[1]); w.w = cvt_pk_bf16(b[2], b[3]); return w; }
__device__ __forceinline__ float silu_f(float x) { return x * __builtin_amdgcn_rcpf(1.f + __expf(-x)); }
__device__ __forceinline__ float wave_sum(float v) {
#pragma unroll
    for (int o = 1; o < 64; o <<= 1) v += __shfl_xor(v, o);
    return v;
}
#define LDS_WAIT() asm volatile("s_waitcnt lgkmcnt(0)" ::: "memory")
__device__ __forceinline__ unsigned char* opaque(unsigned char* p) { size_t z; asm volatile("s_mov_b64 %0, 0" : "=s"(z)); return p + z; }
__device__ __forceinline__ float* opaque(float* p) { size_t z; asm volatile("s_mov_b64 %0, 0" : "=s"(z)); return p + z; }

__device__ __forceinline__ size_t blk(int row, int col, int nt) { return ((size_t)((row >> 8) * nt + (col >> 6)) << 14) + (size_t)(((row & 255) << 6) + (col & 63)); }
__device__ __forceinline__ int win_srccol(int L) {
    if (L < 1280) {
        const int base = L & ~127, Lh = L & 127, wc = Lh >> 5, fq = (Lh >> 3) & 3, n = (Lh >> 2) & 1, i = Lh & 3;
        const int pi = 16 * wc + 4 * fq + i; return base + (pi < 32 ? pi : pi + 32) + 32 * n;
    }
    if (L >= 1536 && L < 2560) {
        const int base = L & ~63, Ls = L & 63, w1 = Ls >> 5, fq = (Ls >> 3) & 3, n = (Ls >> 2) & 1, i = Ls & 3;
        const int pi = 16 * w1 + 4 * fq + i; return base + (pi < 16 ? pi : pi + 16) + 16 * n;
    }
    return L;
}

namespace pg8 {
constexpr int BM = 256, BK = 64, HALF = 128, HTB = HALF * BK * 2, NXCD = 8, WGM = 4;
__host__ __device__ __forceinline__ int lds_byte(int r, int c) { const int st = (r >> 4) * 2 + (c >> 5), rr = r & 15, cc = c & 31, ob = rr * 64 + cc * 2; return st * 1024 + (ob ^ (((ob >> 9) & 1) << 5)); }
__host__ __device__ __forceinline__ void stage_rc(int b, int& R, int& C) { const int st = b / 1024, sb = b % 1024, swz = sb ^ (((sb >> 9) & 1) << 5); R = (st >> 1) * 16 + swz / 64; C = (st & 1) * 32 + (swz % 64) / 2; }
__host__ __device__ __forceinline__ int perm32(int rho) { const int n = rho >> 4, i = rho & 15; return 8 * (i >> 2) + 4 * n + (i & 3); }
struct Unit { int pm, pn; };
struct Gemm { const bf16_t* A; const bf16_t* Bt; int M, N, K; };
struct StaticOrder {
    int nM, nN, nwg, G, c;
    __device__ void init(int M, int N, int G_, int c_) { nM = M / BM; nN = N / BM; nwg = nM * nN; G = G_; c = c_; }
    __device__ bool next(int i, Unit& u) const {
        const long L = (long)i * G + c; if (L >= nwg) return false;
        int wgid = (int)L; { const int q = nwg / NXCD, r = nwg % NXCD, xcd = wgid % NXCD, off = wgid / NXCD; wgid = (xcd < r ? xcd * (q + 1) : r * (q + 1) + (xcd - r) * q) + off; }
        const int nig = WGM * nN, gid = wgid / nig, fm = gid * WGM, gsz = (nM - fm) < WGM ? (nM - fm) : WGM;
        u.pm = fm + ((wgid % nig) % gsz); u.pn = (wgid % nig) / gsz; return true;
    }
};
struct StridedUnits {
    int c, G, total;
    __device__ bool next(int i, Unit& u) const { const int v = c + i * G; if (v >= total) return false; u.pm = v & 1; u.pn = v >> 1; return true; }
};
struct PanelOrder {
    int c, G;
    __device__ bool next(int i, Unit& u) const { if (G != 256 || i >= 3) return false; const int x = c & 7, j = c >> 3; u.pm = (i * 8 + x) * 4 + (j >> 3); u.pn = j & 7; return true; }
};
struct OneUnit {
    int have, pm, pn;
    __device__ bool next(int i, Unit& u) const { if (i > 0 || !have) return false; u.pm = pm; u.pn = pn; return true; }
};

template <class Epi, class Sched, bool ABLK = false, bool BBLK = false>
__device__ __forceinline__ void gemm_phase(LAS unsigned char* lds, const Gemm g, const Sched& S, const Epi& E) {
    int tid = threadIdx.x; asm volatile("" : "+v"(tid));
    const int wid = __builtin_amdgcn_readfirstlane(tid >> 6), lane = tid & 63, wr = wid >> 2, wc = wid & 3, fr = lane & 15, fq = lane >> 4;
    const int K = g.K, nt = K / BK;
    unsigned voffA[2], voffB[2];
#pragma unroll
    for (int i = 0; i < 2; ++i) { int R, C; stage_rc(tid * 16 + i * 8192, R, C); const int Rb = (R & ~31) + perm32(R & 31);
        voffA[i] = ABLK ? (unsigned)(R * 64 + C) * 2u : (unsigned)(R * K + C) * 2u; voffB[i] = BBLK ? (unsigned)(Rb * 64 + C) * 2u : (unsigned)(Rb * K + C) * 2u; }
    const size_t kstepA = ABLK ? (size_t)32768 : (size_t)(BK * 2), kstepB = BBLK ? (size_t)32768 : (size_t)(BK * 2);
    const size_t hstepA = ABLK ? (size_t)16384 : (size_t)HALF * K * 2, hstepB = BBLK ? (size_t)16384 : (size_t)HALF * K * 2;
    const size_t tstepA = (size_t)2 * HALF * K * 2, tstepB = tstepA;
    const unsigned ldsw = (unsigned)wid * 1024u;
    const int aoff = lds_byte(wr * 64 + fr, fq * 8), boff = lds_byte(wc * 32 + fr, fq * 8);
#define PG8_SA(b, h) (((b) * 2 + (h)) * HTB)
#define PG8_SB(b, h) ((4 + (b) * 2 + (h)) * HTB)
#define PG8_STAGE(bufoff, gbase, voff) do { _Pragma("unroll") for (int _i = 0; _i < 2; ++_i) \
        __builtin_amdgcn_global_load_lds((const unsigned*)((const char*)(gbase) + (voff)[_i]), (LAS unsigned*)(lds + (bufoff) + ldsw + _i * 8192), 16, 0, 0); } while (0)
#define PG8_LDA(dst, b, h) do { _Pragma("unroll") for (int m = 0; m < 4; ++m) _Pragma("unroll") for (int k = 0; k < 2; ++k) dst[m][k] = *(const LAS bf16x8*)(lds + PG8_SA(b, h) + aoff + m * 2048 + k * 1024); } while (0)
#define PG8_LDB(dst, b, h) do { _Pragma("unroll") for (int n = 0; n < 2; ++n) _Pragma("unroll") for (int k = 0; k < 2; ++k) dst[n][k] = *(const LAS bf16x8*)(lds + PG8_SB(b, h) + boff + n * 2048 + k * 1024); } while (0)
#define PG8_MMA(ai, bj, At, Bt) do { __builtin_amdgcn_s_setprio(1); _Pragma("unroll") for (int m = 0; m < 4; ++m) _Pragma("unroll") for (int n = 0; n < 2; ++n) _Pragma("unroll") for (int k = 0; k < 2; ++k) \
        acc[ai][bj][m][n] = __builtin_amdgcn_mfma_f32_16x16x32_bf16(Bt[n][k], At[m][k], acc[ai][bj][m][n], 0, 0, 0); __builtin_amdgcn_s_setprio(0); } while (0)
#define PG8_WAIT_V(n) asm volatile("s_waitcnt vmcnt(" #n ")" ::: "memory")
#define PG8_WAIT_L(n) asm volatile("s_waitcnt lgkmcnt(" #n ")" ::: "memory")
#define PG8_BAR __builtin_amdgcn_s_barrier()
#define PG8_SCHED __builtin_amdgcn_sched_barrier(0)
    Unit cur, nxt; int ui = 0;
    if (!S.next(0, cur)) return;
    f32x4 acc[2][2][4][2];
#pragma unroll
    for (int a = 0; a < 2; ++a)
#pragma unroll
        for (int b = 0; b < 2; ++b)
#pragma unroll
            for (int m = 0; m < 4; ++m)
#pragma unroll
                for (int n = 0; n < 2; ++n) acc[a][b][m][n] = (f32x4){0.f, 0.f, 0.f, 0.f};
    bf16x8 At[4][2], B0[2][2], B1[2][2];
    const char* cA = (const char*)g.A + (size_t)cur.pm * tstepA; const char* cB = (const char*)g.Bt + (size_t)cur.pn * tstepB;
    PG8_STAGE(PG8_SB(0, 0), cB, voffB); PG8_STAGE(PG8_SB(0, 1), cB + hstepB, voffB); PG8_STAGE(PG8_SA(0, 0), cA, voffA); PG8_STAGE(PG8_SA(0, 1), cA + hstepA, voffA);
    if (wr == 1) PG8_BAR;
    PG8_WAIT_V(2); PG8_BAR;
    PG8_STAGE(PG8_SB(1, 0), cB + kstepB, voffB); PG8_STAGE(PG8_SA(1, 0), cA + kstepA, voffA); PG8_STAGE(PG8_SB(1, 1), cB + hstepB + kstepB, voffB);
    PG8_WAIT_V(6); PG8_BAR;
    for (;;) {
        const bool has_next = S.next(ui + 1, nxt);
        const char* nA = has_next ? (const char*)g.A + (size_t)nxt.pm * tstepA : cA; const char* nB = has_next ? (const char*)g.Bt + (size_t)nxt.pn * tstepB : cB;
        for (int t = 0; t < nt; t += 2) {
            const bool last = (t == nt - 2);
            const char* a1 = cA + (size_t)(t + 1) * kstepA;
            const char* a2 = last ? nA : cA + (size_t)(t + 2) * kstepA; const char* b2 = last ? nB : cB + (size_t)(t + 2) * kstepB;
            const char* a3 = a2 + kstepA; const char* b3 = b2 + kstepB;
            PG8_LDB(B0, 0, 0); PG8_LDB(B1, 0, 1); PG8_SCHED; PG8_LDA(At, 0, 0); PG8_STAGE(PG8_SA(1, 1), a1 + hstepA, voffA);
            PG8_WAIT_V(8); PG8_WAIT_L(0); PG8_BAR; PG8_MMA(0, 0, At, B0); PG8_MMA(0, 1, At, B1); PG8_BAR; PG8_SCHED;
            PG8_LDA(At, 0, 1); PG8_STAGE(PG8_SB(0, 0), b2, voffB); PG8_STAGE(PG8_SB(0, 1), b2 + hstepB, voffB); PG8_STAGE(PG8_SA(0, 0), a2, voffA);
            PG8_WAIT_V(8); PG8_WAIT_L(0); PG8_BAR; PG8_MMA(1, 0, At, B0); PG8_MMA(1, 1, At, B1); PG8_BAR; PG8_SCHED;
            PG8_LDB(B0, 1, 0); PG8_LDB(B1, 1, 1); PG8_SCHED; PG8_LDA(At, 1, 0); PG8_STAGE(PG8_SA(0, 1), a2 + hstepA, voffA);
            PG8_WAIT_V(8); PG8_WAIT_L(0); PG8_BAR; PG8_MMA(0, 0, At, B0); PG8_MMA(0, 1, At, B1); PG8_BAR; PG8_SCHED;
            PG8_LDA(At, 1, 1); PG8_STAGE(PG8_SB(1, 0), b3, voffB); PG8_STAGE(PG8_SB(1, 1), b3 + hstepB, voffB); PG8_STAGE(PG8_SA(1, 0), a3, voffA);
            PG8_WAIT_V(8); PG8_WAIT_L(0); PG8_BAR; PG8_MMA(1, 0, At, B0); PG8_MMA(1, 1, At, B1); PG8_BAR; PG8_SCHED;
        }
        if (wr == 0) PG8_BAR;
        { int ln = threadIdx.x; asm volatile("" : "+v"(ln)); ln &= 63; E(acc, cur, wr, wc, ln & 15, ln >> 4, lds + LDSX_OFF, ln); }
        if (!has_next) break;
#pragma unroll
        for (int a = 0; a < 2; ++a)
#pragma unroll
            for (int b = 0; b < 2; ++b)
#pragma unroll
                for (int m = 0; m < 4; ++m)
#pragma unroll
                    for (int n = 0; n < 2; ++n) acc[a][b][m][n] = (f32x4){0.f, 0.f, 0.f, 0.f};
        cur = nxt; cA = nA; cB = nB; ++ui;
        if (wr == 1) PG8_BAR;
    }
    PG8_WAIT_V(0);
    PG8_BAR;
#undef PG8_SA
#undef PG8_SB
#undef PG8_STAGE
#undef PG8_LDA
#undef PG8_LDB
#undef PG8_MMA
#undef PG8_WAIT_V
#undef PG8_WAIT_L
#undef PG8_BAR
#undef PG8_SCHED
}
}
using pg8::Unit;

__device__ __forceinline__ int kvrow_of(int row) { return row < NCTX ? row : NCTX + ((row - NCTX) >> 12) * 4352 + 256 + ((row - NCTX) & 4095); }

struct EpiIn {
    unsigned char* ws_; float* out_; int l;
    __device__ __forceinline__ void operator()(f32x4 (&acc)[2][2][4][2], const Unit& u, int wr, int wc, int fr, int fq, LAS unsigned char* ldsx, int lane) const {
        unsigned char* w = opaque(ws_);
        const float* ss = (const float*)(w + WS_SS) + (size_t)(2 * l) * T;
        const float* bias = (const float*)(w + WS_BIASIN) + (size_t)l * 5 * NIN;
        const int pm = u.pm, pn = u.pn; const bool lat = pm >= 32; const int cond = lat ? 1 + ((pm - 32) >> 4) : 0;
        const int cl = wc * 32 + 8 * fq;
        {
            f32x4 bv[2][2];
#pragma unroll
            for (int bj = 0; bj < 2; ++bj)
#pragma unroll
                for (int n = 0; n < 2; ++n) bv[bj][n] = *(const f32x4*)(bias + cond * NIN + pn * 256 + bj * 128 + cl + 4 * n);
#pragma unroll
            for (int ai = 0; ai < 2; ++ai)
#pragma unroll
                for (int m = 0; m < 4; ++m) { const int row = pm * 256 + ai * 128 + wr * 64 + m * 16 + fr; const float rs = rsqrtf(ss[row] * (1.f / DM) + EPS);
#pragma unroll
                    for (int bj = 0; bj < 2; ++bj)
#pragma unroll
                        for (int n = 0; n < 2; ++n) acc[ai][bj][m][n] = acc[ai][bj][m][n] * rs + bv[bj][n]; }
        }
        if (pn <= 4) {
            LAS float* P = (LAS float*)ldsx;
#pragma unroll
            for (int ai = 0; ai < 2; ++ai)
#pragma unroll
                for (int m = 0; m < 4; ++m)
#pragma unroll
                    for (int bj = 0; bj < 2; ++bj) { const f32x4 a = acc[ai][bj][m][0], b = acc[ai][bj][m][1];
                        float s = (a[0] * a[0] + a[1] * a[1]) + (a[2] * a[2] + a[3] * a[3]) + (b[0] * b[0] + b[1] * b[1]) + (b[2] * b[2] + b[3] * b[3]);
                        s += __shfl_xor(s, 16); s += __shfl_xor(s, 32);
                        if (fq == 0) P[((ai * 128 + wr * 64 + m * 16 + fr) * 2 + bj) * 4 + wc] = s; }
            LDS_WAIT(); __builtin_amdgcn_s_barrier(); asm volatile("" ::: "memory");
            const bool isk = (pn == 4);
            const float* gg = (const float*)(w + WS_SMALL) + (isk ? SP_KN : SP_QN) + l * 128;
            const float* rope = (const float*)(w + WS_ROPE);
            bf16_t* QA = (bf16_t*)(w + WS_QA); bf16_t* KA = (bf16_t*)(w + WS_KA); float* oK = opaque(out_) + O_K;
            const int pb = (wc < 2) ? (16 * wc + 4 * fq) : (16 * wc + 4 * fq + 32);
            const f32x4 g0 = *(const f32x4*)(gg + pb), g1 = *(const f32x4*)(gg + pb + 32);
            const int j0 = (16 * wc + 4 * fq) & 31;
#pragma unroll
            for (int ai = 0; ai < 2; ++ai)
#pragma unroll
                for (int m = 0; m < 4; ++m) { const int rt = ai * 128 + wr * 64 + m * 16 + fr, row = pm * 256 + rt;
                    f32x4 cs = (f32x4){1.f, 1.f, 1.f, 1.f}, sn = (f32x4){0.f, 0.f, 0.f, 0.f};
                    if (lat) { const int nt_ = (row - NCTX) & 4095; const int pos = (wc < 2) ? (nt_ >> 6) : (nt_ & 63);
                        cs = *(const f32x4*)(rope + pos * 32 + j0); sn = *(const f32x4*)(rope + 2048 + pos * 32 + j0); }
#pragma unroll
                    for (int bj = 0; bj < 2; ++bj) {
                        const f32x4 pp = *(const LAS f32x4*)(P + (rt * 2 + bj) * 4);
                        const float rh = rsqrtf(((pp[0] + pp[1]) + (pp[2] + pp[3])) * (1.f / 128.f) + EPS);
                        const f32x4 v0 = acc[ai][bj][m][0] * rh * g0, v1 = acc[ai][bj][m][1] * rh * g1;
                        const f32x4 o0 = v0 * cs - v1 * sn, o1 = v1 * cs + v0 * sn;
                        const float qsc = isk ? 1.f : 0.08838834764831845f * 1.4426950408889634f;
                        const u32x4 wv = pack8(o0 * qsc, o1 * qsc);
                        if (!isk) *(u32x4*)(QA + (size_t)row * 1024 + pn * 256 + bj * 128 + cl) = wv;
                        else { *(u32x4*)(KA + (size_t)kvrow_of(row) * 256 + bj * 128 + cl) = wv;
                            if (!lat) { float* o = oK + ((size_t)((pm * 2 + l) * 256 + rt)) * 256 + bj * 128 + pb; *(f32x4*)o = v0; *(f32x4*)(o + 32) = v1; } }
                    } }
        } else if (pn == 5 || pn == 10 || pn == 11) {
            const bool isa = (pn == 5); const int ld = isa ? 256 : 512; const int cb = isa ? 0 : (pn - 10) * 256;
            bf16_t* dst = (bf16_t*)(w + (isa ? WS_VA : WS_VB)); float* od = opaque(out_) + (isa ? O_V : O_DV);
#pragma unroll
            for (int ai = 0; ai < 2; ++ai)
#pragma unroll
                for (int m = 0; m < 4; ++m) { const int rt = ai * 128 + wr * 64 + m * 16 + fr, row = pm * 256 + rt; const size_t kr = (size_t)kvrow_of(row);
#pragma unroll
                    for (int bj = 0; bj < 2; ++bj) { const f32x4 v0 = acc[ai][bj][m][0], v1 = acc[ai][bj][m][1];
                        *(u32x4*)(dst + kr * ld + cb + bj * 128 + cl) = pack8(v0, v1);
                        if (!lat) { float* o = od + ((size_t)((pm * 2 + l) * 256 + rt)) * ld + cb + bj * 128 + cl; *(f32x4*)o = v0; *(f32x4*)(o + 4) = v1; } } }
        } else if (pn >= 6 && pn <= 9) {
            const bool isk = pn >= 8; const int cb = (pn & 1) * 256;
            const int w1 = wc & 1, pi0 = 16 * w1 + 4 * fq, pb = w1 ? pi0 + 16 : pi0, j0 = pi0 & 15;
            const float* rb = (const float*)(w + WS_ROPE) + 4096;
            bf16_t* QB = (bf16_t*)(w + WS_QB); bf16_t* KB = (bf16_t*)(w + WS_KB); float* oDK = opaque(out_) + O_DK;
#pragma unroll
            for (int ai = 0; ai < 2; ++ai)
#pragma unroll
                for (int m = 0; m < 4; ++m) { const int rt = ai * 128 + wr * 64 + m * 16 + fr, row = pm * 256 + rt;
                    f32x4 cs = (f32x4){1.f, 1.f, 1.f, 1.f}, sn = (f32x4){0.f, 0.f, 0.f, 0.f};
                    if (lat) { const int nt_ = (row - NCTX) & 4095; const int pos = w1 ? (nt_ & 63) : (nt_ >> 6);
                        cs = *(const f32x4*)(rb + pos * 16 + j0); sn = *(const f32x4*)(rb + 1024 + pos * 16 + j0); }
#pragma unroll
                    for (int bj = 0; bj < 2; ++bj) { const f32x4 v0 = acc[ai][bj][m][0], v1 = acc[ai][bj][m][1];
                        const f32x4 o0 = v0 * cs - v1 * sn, o1 = v1 * cs + v0 * sn;
                        const float qsc = isk ? 1.f : 0.125f * 1.4426950408889634f;
                        const u32x4 wv = pack8(o0 * qsc, o1 * qsc);
                        if (!isk) *(u32x4*)(QB + (size_t)row * 512 + cb + bj * 128 + cl) = wv;
                        else { *(u32x4*)(KB + (size_t)kvrow_of(row) * 512 + cb + bj * 128 + cl) = wv;
                            if (!lat) { float* o = oDK + ((size_t)((pm * 2 + l) * 256 + rt)) * 512 + cb + bj * 128 + (wc >> 1) * 64 + pb; *(f32x4*)o = v0; *(f32x4*)(o + 16) = v1; } }
                    } }
        } else {
            const int cs_ = (pn - 12) >> 1, cm0 = ((pn - 12) & 1) * 256 + cl;
            bf16_t* FTC = (bf16_t*)(w + WS_FTC); bf16_t* FTL = (bf16_t*)(w + WS_FTL);
            if (lat) {
                const int b = (pm - 32) >> 4, n2 = fr;
#pragma unroll
                for (int ai = 0; ai < 2; ++ai) { const int n1 = ((pm - 32) & 15) * 16 + ai * 8 + wr * 4;
                    bf16_t* base = FTL + (size_t)(128 * (n2 >> 3) + (n2 & 7)) * 512 + cs_ * 256 + n1;
#pragma unroll
                    for (int bj = 0; bj < 2; ++bj)
#pragma unroll
                        for (int n = 0; n < 2; ++n) { const int colid = b * 512 + cm0 + bj * 128 + 4 * n;
                            bf16_t* q = base + (size_t)((colid >> 4) * 256 + 32 * ((colid & 15) >> 2)) * 512;
#pragma unroll
                            for (int i = 0; i < 4; ++i) { u32x2 o; o.x = cvt_pk_bf16(acc[ai][bj][0][n][i], acc[ai][bj][1][n][i]); o.y = cvt_pk_bf16(acc[ai][bj][2][n][i], acc[ai][bj][3][n][i]);
                                *(u32x2*)(q + (size_t)(8 * i) * 512) = o; } } }
            } else {
#pragma unroll
                for (int ai = 0; ai < 2; ++ai)
#pragma unroll
                    for (int m = 0; m < 4; ++m) { const int rt = ai * 128 + wr * 64 + m * 16 + fr;
                        bf16_t* base = FTC + (size_t)pm * 512 * 512 + cs_ * 256 + rt; const size_t ld = 512;
#pragma unroll
                        for (int bj = 0; bj < 2; ++bj)
#pragma unroll
                            for (int n = 0; n < 2; ++n) { const f32x4 v = acc[ai][bj][m][n];
                                const unsigned p0 = cvt_pk_bf16(v[0], v[1]), p1 = cvt_pk_bf16(v[2], v[3]);
                                bf16_t* q = base + (size_t)(cm0 + bj * 128 + 4 * n) * ld;
                                q[0] = (bf16_t)(p0 & 0xffff); q[ld] = (bf16_t)(p0 >> 16); q[2 * ld] = (bf16_t)(p1 & 0xffff); q[3 * ld] = (bf16_t)(p1 >> 16); } }
            }
        }
    }
};

struct EpiDft {
    unsigned char* ws_; int lat;
    __device__ __forceinline__ void operator()(f32x4 (&acc)[2][2][4][2], const Unit& u, int wr, int wc, int fr, int fq, LAS unsigned char* ldsx, int lane) const {
        bf16_t* MIX = (bf16_t*)(opaque(ws_) + WS_MIX);
        const int cl = 1536 + (u.pn & 1) * 256 + wc * 32 + 8 * fq;
        const int tok0 = lat ? NCTX + (u.pn >> 1) * 4096 + u.pm * 256 : (u.pn >> 1) * 256;
#pragma unroll
        for (int ai = 0; ai < 2; ++ai)
#pragma unroll
            for (int m = 0; m < 4; ++m) { const int row = tok0 + ai * 128 + wr * 64 + m * 16 + fr;
#pragma unroll
                for (int bj = 0; bj < 2; ++bj) *(u32x4*)(MIX + (size_t)row * DM + cl + bj * 128) = pack8(acc[ai][bj][m][0], acc[ai][bj][m][1]); }
    }
};

struct EpiFft {
    unsigned char* ws_;
    __device__ __forceinline__ void operator()(f32x4 (&acc)[2][2][4][2], const Unit& u, int wr, int wc, int fr, int fq, LAS unsigned char* ldsx, int lane) const {
        bf16_t* MIX = (bf16_t*)(opaque(ws_) + WS_MIX);
        constexpr float C16[16] = {1.f, 0.9238795325112867f, 0.7071067811865476f, 0.3826834323650898f, 0.f, -0.3826834323650898f, -0.7071067811865476f, -0.9238795325112867f,
                                   -1.f, -0.9238795325112867f, -0.7071067811865476f, -0.3826834323650898f, 0.f, 0.3826834323650898f, 0.7071067811865476f, 0.9238795325112867f};
        const int colid = u.pn * 16 + wc * 4 + fq, b = colid >> 9, cm = colid & 511;
#pragma unroll
        for (int m = 0; m < 4; ++m) {
            const int k1 = u.pm * 128 + wr * 64 + m * 16 + fr;
            float yr[16], yi[16];
#pragma unroll
            for (int n2 = 0; n2 < 16; ++n2) { const float ar = acc[0][n2 >> 3][m][(n2 >> 2) & 1][n2 & 3], ai_ = acc[1][n2 >> 3][m][(n2 >> 2) & 1][n2 & 3];
                const float ph = (float)((n2 * k1) & 4095) * (1.f / 4096.f); const float c = __builtin_amdgcn_cosf(ph), sn = __builtin_amdgcn_sinf(ph);
                yr[n2] = c * ar + sn * ai_; yi[n2] = c * ai_ - sn * ar; }
#pragma unroll
            for (int k2 = 0; k2 < 16; ++k2) { float z = 0.f;
#pragma unroll
                for (int n2 = 0; n2 < 16; ++n2) z += C16[(n2 * k2) & 15] * yr[n2] + C16[(n2 * k2 + 12) & 15] * yi[n2];
                MIX[(size_t)(NCTX + b * 4096 + k1 + 256 * k2) * DM + 1536 + cm] = (bf16_t)(cvt_pk_bf16(z, 0.f) & 0xffff); }
        }
    }
};

constexpr size_t WS_PCNT = 512 * 1024 + 8192;
template <bool FROM_IN, bool FINAL, bool OUTF32 = false>
struct EpiRes {
    unsigned char* ws_; float* out_; const float* xin_c; const float* xin_l; int gate_off  ; int ng_off  ; int nsc_off  ; int ss_idx;
    __device__ __forceinline__ void operator()(f32x4 (&acc)[2][2][4][2], const Unit& u, int wr, int wc, int fr, int fq, LAS unsigned char* ldsx, int lane) const {
        unsigned char* w = opaque(ws_); float* Y = opaque(out_);
        const float* gate = (const float*)(w + WS_MOD) + gate_off; const float* nsc = (const float*)(w + WS_MOD) + nsc_off;
        const float* ng = (const float*)(w + WS_SMALL) + ng_off; const bool hasn = ng_off >= 0;
        bf16_t* XA = (bf16_t*)(w + WS_XA); bf16_t* X16 = (bf16_t*)(w + WS_X16); float* ssn = (float*)(w + WS_SS) + (size_t)ss_idx * T;
        const int pm = u.pm, pn = u.pn; const int cond = pm >= 32 ? 1 + ((pm - 32) >> 4) : 0;
        const int c0 = pn * 256 + wc * 32 + 8 * fq;
        f32x4 gv[2][2], gm[2][2];
#pragma unroll
        for (int bj = 0; bj < 2; ++bj)
#pragma unroll
            for (int n = 0; n < 2; ++n) { const int c = c0 + bj * 128 + 4 * n; gv[bj][n] = *(const f32x4*)(gate + cond * 12288 + c);
                if (FINAL) gm[bj][n] = *(const f32x4*)(ng + c);
                else if (hasn) gm[bj][n] = *(const f32x4*)(ng + c) * (*(const f32x4*)(nsc + cond * 12288 + c) + 1.f); else gm[bj][n] = (f32x4){0.f, 0.f, 0.f, 0.f}; }
#pragma unroll
        for (int ai = 0; ai < 2; ++ai)
#pragma unroll
            for (int m = 0; m < 4; ++m) { const int row = pm * 256 + ai * 128 + wr * 64 + m * 16 + fr;
                bf16_t* xb = X16 + (size_t)row * DM + c0; float s = 0.f;
                const float* xi = (row < NCTX ? xin_c + (size_t)row * DM : xin_l + (size_t)(row - NCTX) * DM) + c0;
#pragma unroll
                for (int bj = 0; bj < 2; ++bj) {
                    f32x4 x0, x1;
                    if (FROM_IN) { x0 = *(const f32x4*)(xi + bj * 128); x1 = *(const f32x4*)(xi + bj * 128 + 4); }
                    else { const u32x4 xw = *(const u32x4*)(xb + bj * 128);
                        x0 = (f32x4){__uint_as_float(xw.x << 16), __uint_as_float(xw.x & 0xffff0000u), __uint_as_float(xw.y << 16), __uint_as_float(xw.y & 0xffff0000u)};
                        x1 = (f32x4){__uint_as_float(xw.z << 16), __uint_as_float(xw.z & 0xffff0000u), __uint_as_float(xw.w << 16), __uint_as_float(xw.w & 0xffff0000u)}; }
                    x0 = x0 + gv[bj][0] * acc[ai][bj][m][0]; x1 = x1 + gv[bj][1] * acc[ai][bj][m][1];
                    s += (x0[0] * x0[0] + x0[1] * x0[1]) + (x0[2] * x0[2] + x0[3] * x0[3]) + (x1[0] * x1[0] + x1[1] * x1[1]) + (x1[2] * x1[2] + x1[3] * x1[3]);
                    if (FINAL) { acc[ai][bj][m][0] = x0; acc[ai][bj][m][1] = x1; }
                    else { if (OUTF32) { float* xo = Y + (size_t)row * DM + c0; *(f32x4*)(xo + bj * 128) = x0; *(f32x4*)(xo + bj * 128 + 4) = x1; }
                        else *(u32x4*)(xb + bj * 128) = pack8(x0, x1);
                        if (hasn) *(u32x4*)(XA + blk(row, c0 + bj * 128, 32)) = pack8(x0 * gm[bj][0], x1 * gm[bj][1]); }
                }
                s += __shfl_xor(s, 16); s += __shfl_xor(s, 32);
                if (fq == 0) atomicAdd(ssn + row, s);
            }
        if (FINAL) {
            unsigned* pc = (unsigned*)(w + WS_PCNT) + 64 * pm;
            asm volatile("s_waitcnt vmcnt(0)" ::: "memory");
            __builtin_amdgcn_s_barrier();
            if (threadIdx.x == 0) {
                __hip_atomic_fetch_add(pc, 1u, __ATOMIC_RELEASE, __HIP_MEMORY_SCOPE_AGENT);
                unsigned sp = 0;
                while (__hip_atomic_load(pc, __ATOMIC_ACQUIRE, __HIP_MEMORY_SCOPE_AGENT) < 8u) { __builtin_amdgcn_s_sleep(2); if (++sp > (1u << 22)) break; }
            }
            __builtin_amdgcn_s_barrier(); asm volatile("" ::: "memory");
#pragma unroll
            for (int ai = 0; ai < 2; ++ai)
#pragma unroll
                for (int m = 0; m < 4; ++m) { const int row = pm * 256 + ai * 128 + wr * 64 + m * 16 + fr;
                    const float rs = rsqrtf(__hip_atomic_load(ssn + row, __ATOMIC_RELAXED, __HIP_MEMORY_SCOPE_AGENT) * (1.f / DM) + EPS);
                    float* xo = Y + (size_t)row * DM + c0;
#pragma unroll
                    for (int bj = 0; bj < 2; ++bj) { *(f32x4*)(xo + bj * 128) = acc[ai][bj][m][0] * rs * gm[bj][0]; *(f32x4*)(xo + bj * 128 + 4) = acc[ai][bj][m][1] * rs * gm[bj][1]; } }
        }
    }
};

struct EpiGU {
    unsigned char* ws_; int l;
    __device__ __forceinline__ void operator()(f32x4 (&acc)[2][2][4][2], const Unit& u, int wr, int wc, int fr, int fq, LAS unsigned char* ldsx, int lane) const {
        unsigned char* w = opaque(ws_);
        const float* ss = (const float*)(w + WS_SS) + (size_t)(2 * l + 1) * T;
        const float* bias = (const float*)(w + WS_BIASGU) + (size_t)l * 5 * NGU;
        const int pm = u.pm, pn = u.pn; const bool lat = pm >= 32; const int cond = lat ? 1 + ((pm - 32) >> 4) : 0;
        const int cl = wc * 32 + 8 * fq, ch0 = pn * 128 + cl;
        {
            f32x4 bv[2][2];
#pragma unroll
            for (int bj = 0; bj < 2; ++bj)
#pragma unroll
                for (int n = 0; n < 2; ++n) bv[bj][n] = *(const f32x4*)(bias + cond * NGU + pn * 256 + bj * 128 + cl + 4 * n);
#pragma unroll
            for (int ai = 0; ai < 2; ++ai)
#pragma unroll
                for (int m = 0; m < 4; ++m) { const int row = pm * 256 + ai * 128 + wr * 64 + m * 16 + fr; const float rs = rsqrtf(ss[row] * (1.f / DM) + EPS);
#pragma unroll
                    for (int bj = 0; bj < 2; ++bj)
#pragma unroll
                        for (int n = 0; n < 2; ++n) acc[ai][bj][m][n] = acc[ai][bj][m][n] * rs + bv[bj][n]; }
        }
        LAS float* E = (LAS float*)ldsx;
#pragma unroll
        for (int ai = 0; ai < 2; ++ai) { const int q = 2 * ai + wr;
            if (fr == 0) { *(LAS f32x4*)(E + (q * 2 + 0) * 128 + cl) = acc[ai][0][0][0]; *(LAS f32x4*)(E + (q * 2 + 0) * 128 + cl + 4) = acc[ai][0][0][1]; }
            if (fr == 15) { *(LAS f32x4*)(E + (q * 2 + 1) * 128 + cl) = acc[ai][0][3][0]; *(LAS f32x4*)(E + (q * 2 + 1) * 128 + cl + 4) = acc[ai][0][3][1]; } }
        LDS_WAIT(); __builtin_amdgcn_s_barrier(); asm volatile("" ::: "memory");
        const float* cw = (const float*)(w + WS_SMALL) + SP_CW + (size_t)l * 3 * DFF; const float* cb = (const float*)(w + WS_SMALL) + SP_CB + (size_t)l * DFF;
        bf16_t* HFF = (bf16_t*)(w + WS_HFF); float* EDGE = (float*)(w + WS_EDGE);
        const int srcR = (lane & 48) | ((fr + 15) & 15), srcL = (lane & 48) | ((fr + 1) & 15);
        const int pml = pm - 32;
#pragma unroll
        for (int n = 0; n < 2; ++n) {
            const int ch = ch0 + 4 * n;
            const f32x4 w0 = *(const f32x4*)(cw + ch), w1 = *(const f32x4*)(cw + DFF + ch), w2 = *(const f32x4*)(cw + 2 * DFF + ch), bb = *(const f32x4*)(cb + ch);
#pragma unroll
            for (int ai = 0; ai < 2; ++ai) { const int q = 2 * ai + wr;
                const f32x4 xprev = q > 0 ? *(const LAS f32x4*)(E + ((q - 1) * 2 + 1) * 128 + cl + 4 * n) : (f32x4){0.f, 0.f, 0.f, 0.f};
                const f32x4 xnext = q < 3 ? *(const LAS f32x4*)(E + ((q + 1) * 2 + 0) * 128 + cl + 4 * n) : (f32x4){0.f, 0.f, 0.f, 0.f};
                f32x4 rRp = xprev, rLc;
#pragma unroll
                for (int i = 0; i < 4; ++i) rLc[i] = __shfl(acc[ai][0][0][n][i], srcL);
#pragma unroll
                for (int m = 0; m < 4; ++m) { const int rt = ai * 128 + wr * 64 + m * 16 + fr; const int row = pm * 256 + rt;
                    f32x4 rR, rLn;
#pragma unroll
                    for (int i = 0; i < 4; ++i) { rR[i] = __shfl(acc[ai][0][m][n][i], srcR);
                        if (m < 3) rLn[i] = __shfl(acc[ai][0][m + 1][n][i], srcL); else rLn[i] = xnext[i]; }
                    const f32x4 prev = (fr == 0) ? rRp : rR;
                    const f32x4 next = (fr == 15) ? rLn : rLc;
                    const f32x4 cv = prev * w0 + acc[ai][0][m][n] * w1 + next * w2 + bb;
                    f32x4 hv;
#pragma unroll
                    for (int i = 0; i < 4; ++i) hv[i] = silu_f(cv[i]) * acc[ai][1][m][n][i];
                    bool skip = false;
                    if (lat && (rt == 0 || rt == 255)) {
                        const int side = rt == 0 ? 0 : 1;
                        float* e = EDGE + ((size_t)(pml * 2 + side) * 3) * DFF + ch;
                        *(f32x4*)e = cv; *(f32x4*)(e + DFF) = acc[ai][0][m][n]; *(f32x4*)(e + 2 * DFF) = acc[ai][1][m][n];
                        skip = side == 0 ? ((pml & 15) != 0) : ((pml & 15) != 15);
                    }
                    if (!skip) { u32x2 o; o.x = cvt_pk_bf16(hv[0], hv[1]); o.y = cvt_pk_bf16(hv[2], hv[3]); *(u32x2*)(HFF + blk(row, ch, 88)) = o; }
                    rRp = rR; rLc = rLn;
                }
            }
        }
    }
};

namespace att {
constexpr int KVBLK = 64;
constexpr size_t SHM_V = KVBLK * 128 * 2, SHM_K = KVBLK * 128 * 2;
constexpr float THR = 8.f;
#define KSWZ(row, colB) ((row) * 256 + ((colB) ^ (((row) & 7) << 4)))
#define SBAR() __builtin_amdgcn_sched_barrier(0)
__device__ __forceinline__ int crow(int r, int hi) { return (r & 3) + 8 * (r >> 2) + 4 * hi; }
__device__ __forceinline__ void partialSM(f32x16& p0, f32x16& p1, float& m_reg, float& alpha, const float thr, const bool first) {
    float pmax = p0[0];
#pragma unroll
    for (int r = 1; r < 16; ++r) pmax = fmaxf(pmax, p0[r]);
#pragma unroll
    for (int r = 0; r < 16; ++r) pmax = fmaxf(pmax, p1[r]);
    { auto rr = __builtin_amdgcn_permlane32_swap(__float_as_uint(pmax), __float_as_uint(pmax), false, false);
      pmax = fmaxf(__uint_as_float(rr[0]), __uint_as_float(rr[1])); }
    if (!first && __builtin_expect(__all(pmax <= thr), 1)) { alpha = 1.f; }
    else { const float d = first ? pmax : fmaxf(pmax, 0.f); alpha = first ? 1.f : __builtin_amdgcn_exp2f(-d); m_reg += d;
#pragma unroll
        for (int r = 0; r < 16; ++r) { p0[r] -= d; p1[r] -= d; } }
#pragma unroll
    for (int r = 0; r < 16; ++r) p0[r] = __builtin_amdgcn_exp2f(p0[r]);
}
__device__ __forceinline__ void finishSM(f32x16& p0, f32x16& p1, float alpha, float& l_reg, bf16x8& pa0, bf16x8& pa1, bf16x8& pa2, bf16x8& pa3) {
#pragma unroll
    for (int r = 0; r < 16; ++r) p1[r] = __builtin_amdgcn_exp2f(p1[r]);
    float ps = 0;
#pragma unroll
    for (int r = 0; r < 16; ++r) ps += p0[r];
#pragma unroll
    for (int r = 0; r < 16; ++r) ps += p1[r];
    { auto rr = __builtin_amdgcn_permlane32_swap(__float_as_uint(ps), __float_as_uint(ps), false, false);
      ps = __uint_as_float(rr[0]) + __uint_as_float(rr[1]); }
    l_reg = l_reg * alpha + ps;
#define PK4(P, BASE, OUT) do { unsigned a0 = cvt_pk_bf16(P[BASE + 0], P[BASE + 1]), a1 = cvt_pk_bf16(P[BASE + 2], P[BASE + 3]);   \
    unsigned b0 = cvt_pk_bf16(P[BASE + 4], P[BASE + 5]), b1 = cvt_pk_bf16(P[BASE + 6], P[BASE + 7]);                              \
    auto r0 = __builtin_amdgcn_permlane32_swap(a0, b0, false, false); auto r1 = __builtin_amdgcn_permlane32_swap(a1, b1, false, false); \
    u32x4 w = {r0[0], r1[0], r0[1], r1[1]}; OUT = *reinterpret_cast<bf16x8*>(&w); } while (0)
    PK4(p0, 0, pa0); PK4(p0, 8, pa1); PK4(p1, 0, pa2); PK4(p1, 8, pa3);
#undef PK4
}
template <int DH>
__device__ __forceinline__ void qkt(f32x16& p0, f32x16& p1, const char* Ks, const bf16x8* qr, int r32, int hi, int koff, float negm) {
#pragma unroll
    for (int r = 0; r < 16; ++r) { p0[r] = negm; p1[r] = negm; }
#pragma unroll
    for (int d0 = 0; d0 < DH; ++d0) { const int cb = (d0 * 16 + hi * 8) * 2 + koff;
        const bf16x8 b0 = *reinterpret_cast<const bf16x8*>(Ks + KSWZ(r32, cb));
        const bf16x8 b1 = *reinterpret_cast<const bf16x8*>(Ks + KSWZ(32 + r32, cb));
        p0 = __builtin_amdgcn_mfma_f32_32x32x16_bf16(b0, qr[d0], p0, 0, 0, 0);
        p1 = __builtin_amdgcn_mfma_f32_32x32x16_bf16(b1, qr[d0], p1, 0, 0, 0); }
}
__device__ __forceinline__ int v_st(int k, int c) { const int kk = (k & ~0xC) | ((k & 4) << 1) | ((k & 8) >> 1); return ((kk >> 3) * 4 + (c >> 5)) * 512 + ((kk & 7) * 32 + (c & 31)) * 2; }
__device__ __forceinline__ int v_rd_base(int lane) { return ((lane & 3) << 3) | (((lane >> 2) & 3) << 6) | (((lane >> 4) & 1) << 5) | (((lane >> 5) & 1) << 8); }
constexpr int v_rd_off(int d0, int ks, int half) { return d0 * 512 + ks * 4096 + half * 2048; }
template <int OFF> __device__ __forceinline__ s16x4 tr_read(int vb) {
    s16x4 r; asm volatile("ds_read_b64_tr_b16 %0, %1 offset:%2" : "=&v"(r) : "v"(vb), "i"(OFF) : "memory"); return r;
}
template <int D0> __device__ __forceinline__ void pv_one(f32x16& od, int vb, bf16x8 pa0, bf16x8 pa1, bf16x8 pa2, bf16x8 pa3) {
    const s16x4 l0 = tr_read<v_rd_off(D0, 0, 0)>(vb), h0 = tr_read<v_rd_off(D0, 0, 1)>(vb), l1 = tr_read<v_rd_off(D0, 1, 0)>(vb), h1 = tr_read<v_rd_off(D0, 1, 1)>(vb);
    const s16x4 l2 = tr_read<v_rd_off(D0, 2, 0)>(vb), h2 = tr_read<v_rd_off(D0, 2, 1)>(vb), l3 = tr_read<v_rd_off(D0, 3, 0)>(vb), h3 = tr_read<v_rd_off(D0, 3, 1)>(vb);
    asm volatile("s_waitcnt lgkmcnt(0)" ::: "memory"); SBAR();
#define PK(L, H) (bf16x8){L[0], L[1], L[2], L[3], H[0], H[1], H[2], H[3]}
    od = __builtin_amdgcn_mfma_f32_32x32x16_bf16(pa0, PK(l0, h0), od, 0, 0, 0);
    od = __builtin_amdgcn_mfma_f32_32x32x16_bf16(pa1, PK(l1, h1), od, 0, 0, 0);
    od = __builtin_amdgcn_mfma_f32_32x32x16_bf16(pa2, PK(l2, h2), od, 0, 0, 0);
    od = __builtin_amdgcn_mfma_f32_32x32x16_bf16(pa3, PK(l3, h3), od, 0, 0, 0);
#undef PK
}
__device__ __forceinline__ void pv_d0(f32x16* o, int vb, bf16x8 pa0, bf16x8 pa1, bf16x8 pa2, bf16x8 pa3) {
    pv_one<0>(o[0], vb, pa0, pa1, pa2, pa3); pv_one<1>(o[1], vb, pa0, pa1, pa2, pa3); pv_one<2>(o[2], vb, pa0, pa1, pa2, pa3); pv_one<3>(o[3], vb, pa0, pa1, pa2, pa3);
}
template <int DH, int LDK>
__device__ __forceinline__ void body(const bf16_t* __restrict__ Qw, const bf16_t* __restrict__ Kh, const bf16_t* __restrict__ Vh, int seq, int koff, float C, char* lds, f32x16 (&o)[4]) {
    int tid = threadIdx.x; asm volatile("" : "+v"(tid));
    const int wid = tid >> 6, lane = tid & 63, r32 = lane & 31, hi = lane >> 5;
    char* V_lds = lds; char* K_lds = lds + 2 * SHM_V;
    float* ws = (float*)(lds + 2 * SHM_V + 2 * SHM_K) + wid * 64; float* li_l = ws; float* al_l = ws + 32;
    float m_reg = 0.f, l_reg = 0; bf16x8 qr[DH];
    const float thr = THR * 1.4426950408889634f;
#pragma unroll
    for (int d = 0; d < 4; ++d) o[d] = f32x16{};
#pragma unroll
    for (int d0 = 0; d0 < DH; ++d0) qr[d0] = *reinterpret_cast<const bf16x8*>(Qw + d0 * 16);
    const int sr = tid >> 4, sc = (tid & 15) * 8, vst0 = v_st(sr, sc), vst1 = v_st(32 + sr, sc);
    const int vb0 = (int)(uintptr_t)V_lds + v_rd_base(lane);
    struct { bf16x8 vs0, vs1, ks0, ks1; } sr_[2];
#define SLOAD(i, k0) do { sr_[i].vs0 = *(const bf16x8*)(&Vh[(long)((k0) + sr) * LDK + sc]); sr_[i].vs1 = *(const bf16x8*)(&Vh[(long)((k0) + 32 + sr) * LDK + sc]); \
    sr_[i].ks0 = *(const bf16x8*)(&Kh[(long)((k0) + sr) * LDK + sc]); sr_[i].ks1 = *(const bf16x8*)(&Kh[(long)((k0) + 32 + sr) * LDK + sc]); } while (0)
#define SWRITE(b, i) do { *(bf16x8*)(V_lds + (b) * SHM_V + vst0) = sr_[i].vs0;          \
    *(bf16x8*)(V_lds + (b) * SHM_V + vst1) = sr_[i].vs1; const int kc = sc * 2;               \
    *(bf16x8*)(K_lds + (b) * SHM_K + KSWZ(sr, kc)) = sr_[i].ks0;                       \
    *(bf16x8*)(K_lds + (b) * SHM_K + KSWZ(32 + sr, kc)) = sr_[i].ks1; } while (0)
#define SWAIT() asm volatile("s_waitcnt vmcnt(4)" ::: "memory")
#define RESC(a) do { if (__any((a) < 1.f)) { if (hi == 0) al_l[r32] = (a); asm volatile("s_waitcnt lgkmcnt(0)" ::: "memory"); \
    _Pragma("unroll") for (int d = 0; d < 4; ++d) _Pragma("unroll") for (int r = 0; r < 16; ++r) o[d][r] *= al_l[crow(r, hi)]; } } while (0)
    f32x16 pA0, pA1, pB0, pB1; float alA, alB; bf16x8 pa0, pa1, pa2, pa3; const int NT = seq / KVBLK;
    constexpr int SE = 0, SO = 1;
    SLOAD(SE, 0); asm volatile("s_waitcnt vmcnt(0)" ::: "memory"); SWRITE(0, SE); __syncthreads();
    qkt<DH>(pA0, pA1, K_lds, qr, r32, hi, koff, 0.f); partialSM(pA0, pA1, m_reg, alA, thr, true);
    SLOAD(SO, KVBLK); if (2 < NT) SLOAD(SE, 2 * KVBLK);
    SWAIT(); SWRITE(1, SO); __syncthreads();
    for (int j = 1; j + 1 < NT; j += 2) {
        SBAR(); qkt<DH>(pB0, pB1, K_lds + SHM_K, qr, r32, hi, koff, -m_reg);
        finishSM(pA0, pA1, alA, l_reg, pa0, pa1, pa2, pa3); SBAR();
        SLOAD(SO, (j + 2) * KVBLK); SBAR();
        pv_d0(o, vb0, pa0, pa1, pa2, pa3); partialSM(pB0, pB1, m_reg, alB, thr, false);
        __syncthreads(); SWAIT(); SWRITE(0, SE);
        RESC(alB); __syncthreads();
        SBAR(); qkt<DH>(pA0, pA1, K_lds, qr, r32, hi, koff, -m_reg);
        finishSM(pB0, pB1, alB, l_reg, pa0, pa1, pa2, pa3); SBAR();
        if (j + 3 < NT) SLOAD(SE, (j + 3) * KVBLK); SBAR();
        pv_d0(o, vb0 + (int)SHM_V, pa0, pa1, pa2, pa3); partialSM(pA0, pA1, m_reg, alA, thr, false);
        __syncthreads(); SWAIT(); SWRITE(1, SO);
        RESC(alA); __syncthreads();
    }
    SBAR(); qkt<DH>(pB0, pB1, K_lds + SHM_K, qr, r32, hi, koff, -m_reg);
    finishSM(pA0, pA1, alA, l_reg, pa0, pa1, pa2, pa3); SBAR();
    pv_d0(o, vb0, pa0, pa1, pa2, pa3); partialSM(pB0, pB1, m_reg, alB, thr, false);
    __syncthreads(); RESC(alB);
    finishSM(pB0, pB1, alB, l_reg, pa0, pa1, pa2, pa3); SBAR();
    pv_d0(o, vb0 + (int)SHM_V, pa0, pa1, pa2, pa3);
    if (hi == 0) li_l[r32] = l_reg; asm volatile("s_waitcnt lgkmcnt(0)" ::: "memory");
#pragma unroll
    for (int r = 0; r < 16; ++r) { const float rl = __builtin_amdgcn_rcpf(li_l[crow(r, hi)]);
#pragma unroll
        for (int d = 0; d < 4; ++d) o[d][r] *= rl; }
#undef SLOAD
#undef SWRITE
#undef SWAIT
#undef RESC
}
}

__device__ __forceinline__ void transpose_item(const float* W, int K, int N, bf16_t* WT, int row0, int k0, int srccol4, LAS float* scr, int lane) {
    const int r = lane >> 3, c4 = lane & 7;
    f32x4 v[8];
#pragma unroll
    for (int i = 0; i < 8; ++i) v[i] = *(const f32x4*)(W + (size_t)(k0 + 8 * i + r) * N + srccol4);
#pragma unroll
    for (int i = 0; i < 8; ++i) { LAS float* d = scr + (8 * i + r) * 33 + 4 * c4; d[0] = v[i][0]; d[1] = v[i][1]; d[2] = v[i][2]; d[3] = v[i][3]; }
    LDS_WAIT(); asm volatile("" ::: "memory");
    const int c = lane & 7;
#pragma unroll
    for (int j = 0; j < 4; ++j) { const int n = (lane >> 3) + 8 * j; const LAS float* sp = scr + (8 * c) * 33 + n;
        u32x4 o; o.x = cvt_pk_bf16(sp[0 * 33], sp[1 * 33]); o.y = cvt_pk_bf16(sp[2 * 33], sp[3 * 33]); o.z = cvt_pk_bf16(sp[4 * 33], sp[5 * 33]); o.w = cvt_pk_bf16(sp[6 * 33], sp[7 * 33]);
        *(u32x4*)(WT + blk(row0 + n, k0 + 8 * c, K >> 6)) = o; }
    LDS_WAIT(); asm volatile("" ::: "memory");
}

#define XB_TMO      128
#define XB_XCNT(j)  (256  + 64 * (j))
#define XB_XSUB(j)  (1280 + 64 * (j))
#define XB_XGEN(j)  (2304 + 64 * (j))
#define XB_TOP      3328
#define XB_TOPGEN   3392
#define XCD_BAR_WORDS 3456
#define XB_SPIN_CAP (1u << 18)
__device__ __forceinline__ unsigned xb_ld(unsigned* p)              { return __hip_atomic_load(p, __ATOMIC_RELAXED, __HIP_MEMORY_SCOPE_AGENT); }
__device__ __forceinline__ unsigned xb_add(unsigned* p, unsigned v) { return __hip_atomic_fetch_add(p, v, __ATOMIC_RELAXED, __HIP_MEMORY_SCOPE_AGENT); }
__device__ __forceinline__ unsigned xb_xcc_id() { return (unsigned)__builtin_amdgcn_s_getreg((3 << 11) | 20) & 0xFu; }
#define XB_SPIN(cond, bar) do { unsigned _sp = 0; while (cond) { __builtin_amdgcn_s_sleep(1); \
    if ((++_sp & 255u) == 0u) { if (xb_ld(&(bar)[XB_TMO])) break; if (_sp > XB_SPIN_CAP) { atomicAdd(&(bar)[XB_TMO], 1u); break; } } } } while (0)
struct XcdBarrier { unsigned* bar; unsigned x; volatile LAS unsigned* st; };
__device__ __forceinline__ XcdBarrier xcd_barrier_post(unsigned* bar, volatile LAS unsigned* st) {
    XcdBarrier b; b.bar = bar; b.x = xb_xcc_id(); b.st = st;
    if (threadIdx.x == 0) (void)xb_add(&bar[XB_XCNT(b.x)], 1u);
    return b;
}
__device__ __forceinline__ void xcd_barrier_complete(unsigned* bar, unsigned x, unsigned& nloc, unsigned& nx) {
    const unsigned G = gridDim.x * gridDim.y * gridDim.z;
    unsigned sum, cnt, mine, sp = 0u;
    for (;;) {
        sum = 0u; cnt = 0u; mine = 0u;
#pragma unroll
        for (unsigned j = 0; j < 16; ++j) { const unsigned c = xb_ld(&bar[XB_XCNT(j)]); sum += c; cnt += (c > 0u) ? 1u : 0u; mine = (j == x) ? c : mine; }
        if (sum == G) break;
        __builtin_amdgcn_s_sleep(1);
        if ((++sp & 255u) == 0u) { if (xb_ld(&bar[XB_TMO])) break; if (sp > XB_SPIN_CAP) { atomicAdd(&bar[XB_TMO], 1u); break; } }
    }
    nloc = mine > 0u ? mine : 1u; nx = cnt > 0u ? cnt : 1u;
}
__device__ __forceinline__ void xcd_barrier(const XcdBarrier& b) {
    asm volatile("s_waitcnt vmcnt(0)" ::: "memory");
    __syncthreads();
    if (threadIdx.x == 0) {
        unsigned* bar = b.bar;
        __builtin_amdgcn_s_waitcnt(0);
        unsigned nloc = b.st[0], nx = b.st[1];
        if (nloc == 0u) { xcd_barrier_complete(bar, b.x, nloc, nx); b.st[0] = nloc; b.st[1] = nx; }
        const unsigned old = xb_add(&bar[XB_XSUB(b.x)], 1u);
        const unsigned gen = old / nloc;
        if (old + 1u == (gen + 1u) * nloc) {
            __builtin_amdgcn_fence(__ATOMIC_RELEASE, "agent");
            asm volatile("s_waitcnt vmcnt(0)" ::: "memory");
            const unsigned og = xb_add(&bar[XB_TOP], 1u);
            const unsigned tg = og / nx;
            if (og + 1u == (tg + 1u) * nx) xb_add(&bar[XB_TOPGEN], 1u);
            else XB_SPIN(xb_ld(&bar[XB_TOPGEN]) == tg, bar);
            __builtin_amdgcn_fence(__ATOMIC_ACQUIRE, "agent");
            xb_add(&bar[XB_XGEN(b.x)], 1u);
            asm volatile("s_waitcnt vmcnt(0)" ::: "memory");
        } else {
            XB_SPIN(xb_ld(&bar[XB_XGEN(b.x)]) == gen, bar);
            __builtin_amdgcn_fence(__ATOMIC_ACQUIRE, "agent");
            asm volatile("s_waitcnt vmcnt(0)" ::: "memory");
        }
    }
    __syncthreads();
}

__global__ void __launch_bounds__(512, 2) fwd_megakernel(Params p) {
    extern __shared__ __attribute__((aligned(16))) unsigned char lds_raw[];
    cg::grid_group grid = cg::this_grid();
    LAS unsigned char* lds = (LAS unsigned char*)lds_raw;
    const int G = gridDim.x, bid = blockIdx.x;
    const int NGW = G * 8; const long NGT = (long)G * 512;
    unsigned char* const ws0 = p.ws; float* const out0 = p.out;
    { volatile LAS unsigned* st0 = (volatile LAS unsigned*)(lds + LDSX_OFF + 12288 + 64); if (threadIdx.x < 2) st0[threadIdx.x] = 0u; }
    __syncthreads();
    {
        constexpr long NZ = (long)(WS_BAR + 16384) / 16;
        for (long i = (long)blockIdx.x * 512 + threadIdx.x; i < NZ; i += (long)gridDim.x * 512) *(u32x4*)(ws0 + WS_CTL + i * 16) = (u32x4){0u, 0u, 0u, 0u};
    }
#define GSYNC() do { XcdBarrier xb_; xb_.bar = (unsigned*)(opaque(ws0) + WS_BAR); xb_.x = xb_xcc_id(); xb_.st = (volatile LAS unsigned*)(lds + LDSX_OFF + 12288 + 64); xcd_barrier(xb_); } while (0)
#define TIDS() int tid = threadIdx.x; asm volatile("" : "+v"(tid)); const int lane = tid & 63, wave = __builtin_amdgcn_readfirstlane(tid >> 6); const int gw = bid * 8 + wave; const long gtid = (long)bid * 512 + tid; (void)lane; (void)gw; (void)gtid;

    if (bid < 192) { TIDS();
        const float* cvec = p.in[6]; const float* c_ctx = p.in[7]; const float* w_ada = p.in[10]; const float* b_ada = p.in[11];
        float* MOD = (float*)(ws0 + WS_MOD);
        LAS float* sl = (LAS float*)lds;
        LAS float* red = (LAS float*)(lds + 40960);
        for (int i = tid; i < 5 * DM; i += 512) { const int cnd = i / DM, k = i % DM; const float v = cnd == 0 ? c_ctx[k] : cvec[(cnd - 1) * DM + k]; sl[i] = silu_f(v); }
        __syncthreads();
        const int l = bid / 96, cgp = bid % 96, tx = tid & 31, ky = tid >> 5;
        const float* Wp = w_ada + (size_t)l * DM * 12288 + (size_t)(ky * 128) * 12288 + cgp * 128 + 4 * tx;
        f32x4 a[5];
#pragma unroll
        for (int c = 0; c < 5; ++c) a[c] = (f32x4){0.f, 0.f, 0.f, 0.f};
#pragma unroll 8
        for (int k = 0; k < 128; ++k) { const f32x4 wv = *(const f32x4*)(Wp + (size_t)k * 12288);
#pragma unroll
            for (int c = 0; c < 5; ++c) a[c] += wv * sl[c * DM + ky * 128 + k]; }
#pragma unroll
        for (int c = 0; c < 5; ++c) *(LAS f32x4*)(red + (ky * 5 + c) * 128 + 4 * tx) = a[c];
        __syncthreads();
        for (int i = tid; i < 640; i += 512) { const int c = i >> 7, col = i & 127; float sm = 0.f;
#pragma unroll
            for (int k = 0; k < 16; ++k) sm += red[(k * 5 + c) * 128 + col];
            MOD[(size_t)(l * 5 + c) * 12288 + cgp * 128 + col] = sm + b_ada[l * 12288 + cgp * 128 + col]; }
        __syncthreads();
    }
    {
        TIDS();
        const float* w_in = p.in[12]; const float* w_out = p.in[20]; const float* w_gate = p.in[21]; const float* w_up = p.in[22]; const float* w_down = p.in[25];
        bf16_t* WIN = (bf16_t*)(ws0 + WS_WIN); bf16_t* WOUT = (bf16_t*)(ws0 + WS_WOUT); bf16_t* WGU = (bf16_t*)(ws0 + WS_WGU); bf16_t* WDN = (bf16_t*)(ws0 + WS_WDN);
        LAS float* scr = (LAS float*)(lds + wave * 16384);
        constexpr int I_IN = 32 * 96, I_OUT = 32 * 64, I_GU = 32 * 352, I_DN = 88 * 64, I_L = I_IN + I_OUT + I_GU + I_DN;
        for (int it = gw; it < 2 * I_L; it += NGW) {
            const int l = it / I_L; int r = it % I_L;
            if (r < I_IN) { const int kb = r / 96, nb = r % 96; const int L = nb * 32 + 4 * (lane & 7);
                transpose_item(w_in + (size_t)l * DM * DIN, DM, DIN, WIN + (size_t)l * NIN * DM, nb * 32, kb * 64, win_srccol(L), scr, lane); continue; }
            r -= I_IN;
            if (r < I_OUT) { const int kb = r / 64, nb = r % 64;
                transpose_item(w_out + (size_t)l * DM * DM, DM, DM, WOUT + (size_t)l * DM * DM, nb * 32, kb * 64, nb * 32 + 4 * (lane & 7), scr, lane); continue; }
            r -= I_OUT;
            if (r < I_GU) { const int kb = r / 352, nb = r % 352; const int L0 = nb * 32, pn = L0 >> 8, bj = (L0 >> 7) & 1, lam0 = L0 & 127;
                transpose_item((bj ? w_up : w_gate) + (size_t)l * DM * DFF, DM, DFF, WGU + (size_t)l * NGU * DM, L0, kb * 64, pn * 128 + lam0 + 4 * (lane & 7), scr, lane); continue; }
            r -= I_GU;
            { const int kb = r / 64, nb = r % 64;
                transpose_item(w_down + (size_t)l * DFF * DM, DFF, DM, WDN + (size_t)l * DM * DFF, nb * 32, kb * 64, nb * 32 + 4 * (lane & 7), scr, lane); }
        }
        LAS float* trg = scr + 16 * 128;
        for (int j = lane; j < 128; j += 64) { trg[j] = __builtin_amdgcn_cosf((float)j * (1.f / 128.f)); trg[128 + j] = __builtin_amdgcn_sinf((float)j * (1.f / 128.f)); }
        LDS_WAIT();
        for (int it = gw; it < 2 * 2 * 4 * 128 * 4; it += NGW) {
            const int mb = it & 3, kb = (it >> 2) & 127, g = (it >> 9) & 3, cs = (it >> 11) & 1, l = it >> 12;
            const float* Wl = w_in + (size_t)l * DM * DIN + 3072 + g * 128;
#pragma unroll
            for (int i = 0; i < 8; ++i) { const int kk = 2 * i + (lane >> 5);
                *(LAS f32x4*)(scr + kk * 128 + 4 * (lane & 31)) = *(const f32x4*)(Wl + (size_t)(kb * 16 + kk) * DIN + 4 * (lane & 31)); }
            LDS_WAIT(); asm volatile("" ::: "memory");
            const int m = mb * 32 + (lane & 31), kh = lane >> 5;
            float a8[8];
#pragma unroll
            for (int i = 0; i < 8; ++i) a8[i] = 0.f;
            const LAS float* tt = trg + cs * 128;
            for (int c = 0; c < 128; ++c) { const float tv = tt[(c * m) & 127];
#pragma unroll
                for (int i = 0; i < 8; ++i) a8[i] += scr[(kh * 8 + i) * 128 + c] * tv; }
            u32x4 o; o.x = cvt_pk_bf16(a8[0], a8[1]); o.y = cvt_pk_bf16(a8[2], a8[3]); o.z = cvt_pk_bf16(a8[4], a8[5]); o.w = cvt_pk_bf16(a8[6], a8[7]);
            *(u32x4*)(WIN + (size_t)l * NIN * DM + blk(3072 + cs * 512 + g * 128 + m, kb * 16 + kh * 8, 32)) = o;
            LDS_WAIT(); asm volatile("" ::: "memory");
        }
    }
    {
        TIDS();
        bf16_t* DFTC = (bf16_t*)(ws0 + WS_DFTC); bf16_t* DFTL = (bf16_t*)(ws0 + WS_DFTL); float* ROPE = (float*)(ws0 + WS_ROPE); float* LAM = (float*)(ws0 + WS_LAM);
        const float scl = 1.f / sqrtf(4096.f * 128.f);
        for (long i = gtid; i < 512L * 512 / 8; i += NGT) { const int R = (int)(i >> 6), c8 = (int)(i & 63) * 8, cs = c8 >> 8, n0 = c8 & 255;
            const int im = (R >> 7) & 1, k1 = (R >> 8) * 128 + (R & 127);
            float v[8];
#pragma unroll
            for (int j = 0; j < 8; ++j) { const float ph = (float)((k1 * (n0 + j)) & 255) * (1.f / 256.f);
                const float c = __builtin_amdgcn_cosf(ph), sn = __builtin_amdgcn_sinf(ph);
                v[j] = (im == 0 ? (cs == 0 ? c : -sn) : (cs == 0 ? -sn : -c)) * scl; }
            u32x4 o; o.x = cvt_pk_bf16(v[0], v[1]); o.y = cvt_pk_bf16(v[2], v[3]); o.z = cvt_pk_bf16(v[4], v[5]); o.w = cvt_pk_bf16(v[6], v[7]);
            *(u32x4*)(DFTL + i * 8) = o; }
        const float scc = 1.f / sqrtf(256.f * 128.f);
        for (long i = gtid; i < 256L * 512 / 8; i += NGT) { const int k = (int)(i >> 6), c8 = (int)(i & 63) * 8, cs = c8 >> 8, n0 = c8 & 255;
            float v[8];
#pragma unroll
            for (int j = 0; j < 8; ++j) { const float ph = (float)((k * (n0 + j)) & 255) * (1.f / 256.f); v[j] = (cs ? -__builtin_amdgcn_sinf(ph) : __builtin_amdgcn_cosf(ph)) * scc; }
            u32x4 o; o.x = cvt_pk_bf16(v[0], v[1]); o.y = cvt_pk_bf16(v[2], v[3]); o.z = cvt_pk_bf16(v[4], v[5]); o.w = cvt_pk_bf16(v[6], v[7]);
            *(u32x4*)(DFTC + i * 8) = o; }
        for (long i = gtid; i < 2048 + 1024; i += NGT) {
            if (i < 2048) { const int pos = (int)i >> 5, j = (int)i & 31; const float ang = (float)pos * powf(10000.f, -(float)j / 32.f); ROPE[i] = cosf(ang); ROPE[2048 + i] = sinf(ang); }
            else { const int ii = (int)i - 2048, pos = ii >> 4, j = ii & 15; const float ang = (float)pos * powf(10000.f, -(float)j / 16.f); ROPE[4096 + ii] = cosf(ang); ROPE[5120 + ii] = sinf(ang); }
        }
        if (gtid < 2) { const int l = (int)gtid; float s1 = 0.f, s2 = 0.f;
            const float* lq1 = p.in[15]; const float* lk1 = p.in[16]; const float* lq2 = p.in[17]; const float* lk2 = p.in[18];
            for (int j = 0; j < 64; ++j) { s1 += lq1[l * 64 + j] * lk1[l * 64 + j]; s2 += lq2[l * 64 + j] * lk2[l * 64 + j]; }
            LAM[l] = expf(s1) - expf(s2) + (0.8f - 0.6f * expf(-0.3f * (float)l)); }
        float* SP = (float*)(ws0 + WS_SMALL);
        for (long i = gtid; i < SP_END; i += NGT) { const int j = (int)i; float v;
            if (j < SP_N2) v = p.in[8][j - SP_N1]; else if (j < SP_QN) v = p.in[9][j - SP_N2]; else if (j < SP_KN) v = p.in[13][j - SP_QN];
            else if (j < SP_SUB) v = p.in[14][j - SP_KN]; else if (j < SP_FIN) v = p.in[19][j - SP_SUB]; else if (j < SP_CB) v = p.in[26][j - SP_FIN];
            else if (j < SP_CW) v = p.in[24][j - SP_CB]; else v = p.in[23][j - SP_CW];
            SP[j] = v; }
        bf16_t* CST = (bf16_t*)(ws0 + WS_CST);
        for (int r = gw; r < 2048; r += NGW) {
            const int l = r >> 10, b = (r >> 8) & 3, j = r & 255; const size_t cro = (size_t)((b * 2 + l) * 256 + j);
            bf16_t* dst = CST + (size_t)r * 1536;
            { const int L = lane * 4; const int sc_ = win_srccol(L);
              const f32x4 v = *(const f32x4*)(p.in[2] + cro * 256 + sc_); u32x2 wv; wv.x = cvt_pk_bf16(v[0], v[1]); wv.y = cvt_pk_bf16(v[2], v[3]); *(u32x2*)(dst + L) = wv;
              const f32x4 v2 = *(const f32x4*)(p.in[3] + cro * 256 + L); u32x2 w2; w2.x = cvt_pk_bf16(v2[0], v2[1]); w2.y = cvt_pk_bf16(v2[2], v2[3]); *(u32x2*)(dst + 256 + L) = w2; }
#pragma unroll
            for (int h2 = 0; h2 < 2; ++h2) { const int L = h2 * 256 + lane * 4; const int sc_ = win_srccol(2048 + L) - 2048;
              const f32x4 v = *(const f32x4*)(p.in[4] + cro * 512 + sc_); u32x2 wv; wv.x = cvt_pk_bf16(v[0], v[1]); wv.y = cvt_pk_bf16(v[2], v[3]); *(u32x2*)(dst + 512 + L) = wv;
              const f32x4 v2 = *(const f32x4*)(p.in[5] + cro * 512 + L); u32x2 w2; w2.x = cvt_pk_bf16(v2[0], v2[1]); w2.y = cvt_pk_bf16(v2[2], v2[3]); *(u32x2*)(dst + 1024 + L) = w2; }
        }
    }
    grid.sync();
    (void)xcd_barrier_post((unsigned*)(ws0 + WS_BAR), (volatile LAS unsigned*)(lds + LDSX_OFF + 12288 + 64));
    {
        TIDS();
        const float* x_prompt = p.in[0]; const float* x_sample = p.in[1]; const float* norm1_g = p.in[8];
        const float* MOD = (const float*)(ws0 + WS_MOD); float* SS = (float*)(ws0 + WS_SS); bf16_t* XA = (bf16_t*)(ws0 + WS_XA);
        for (int row = gw; row < T; row += NGW) {
            const int cond = row < NCTX ? 0 : 1 + ((row - NCTX) >> 12);
            const float* xr = row < NCTX ? x_prompt + (size_t)row * DM : x_sample + (size_t)(row - NCTX) * DM;
            const float* sc = MOD + (size_t)(0 * 5 + cond) * 12288 + 1 * DM;
            float sm = 0.f;
#pragma unroll
            for (int j = 0; j < 4; ++j) { const int c = j * 512 + lane * 8;
                const f32x4 x0 = *(const f32x4*)(xr + c), x1 = *(const f32x4*)(xr + c + 4);
                const f32x4 g0 = *(const f32x4*)(norm1_g + c) * (*(const f32x4*)(sc + c) + 1.f), g1 = *(const f32x4*)(norm1_g + c + 4) * (*(const f32x4*)(sc + c + 4) + 1.f);
                sm += (x0[0] * x0[0] + x0[1] * x0[1]) + (x0[2] * x0[2] + x0[3] * x0[3]) + (x1[0] * x1[0] + x1[1] * x1[1]) + (x1[2] * x1[2] + x1[3] * x1[3]);
                *(u32x4*)(XA + blk(row, c, 32)) = pack8(x0 * g0, x1 * g1); }
            sm = wave_sum(sm);
            if (lane == 0) SS[row] = sm;
        }
        const bf16_t* WIN = (const bf16_t*)(ws0 + WS_WIN); const bf16_t* WGU = (const bf16_t*)(ws0 + WS_WGU);
        float* BIASIN = (float*)(ws0 + WS_BIASIN); float* BIASGU = (float*)(ws0 + WS_BIASGU);
        for (int it = gw; it < 2 * (NIN + NGU); it += NGW) {
            const int l = it / (NIN + NGU), r = it % (NIN + NGU); const bool isin = r < NIN; const int L = isin ? r : r - NIN;
            const bf16_t* br = isin ? WIN + (size_t)l * NIN * DM : WGU + (size_t)l * NGU * DM;
            float a[5] = {0.f, 0.f, 0.f, 0.f, 0.f};
#pragma unroll
            for (int j = 0; j < 4; ++j) { const int c = j * 512 + lane * 8; const u32x4 wv = *(const u32x4*)(br + blk(L, c, 32));
                float wf[8]; wf[0] = __uint_as_float(wv.x << 16); wf[1] = __uint_as_float(wv.x & 0xffff0000u); wf[2] = __uint_as_float(wv.y << 16); wf[3] = __uint_as_float(wv.y & 0xffff0000u);
                wf[4] = __uint_as_float(wv.z << 16); wf[5] = __uint_as_float(wv.z & 0xffff0000u); wf[6] = __uint_as_float(wv.w << 16); wf[7] = __uint_as_float(wv.w & 0xffff0000u);
#pragma unroll
                for (int cnd = 0; cnd < 5; ++cnd) { const float* sh = MOD + (size_t)(l * 5 + cnd) * 12288 + (isin ? 0 : 3 * DM) + c;
                    const f32x4 s0 = *(const f32x4*)sh, s1 = *(const f32x4*)(sh + 4);
                    a[cnd] += (wf[0] * s0[0] + wf[1] * s0[1]) + (wf[2] * s0[2] + wf[3] * s0[3]) + (wf[4] * s1[0] + wf[5] * s1[1]) + (wf[6] * s1[2] + wf[7] * s1[3]); } }
#pragma unroll
            for (int cnd = 0; cnd < 5; ++cnd) { const float sm = wave_sum(a[cnd]);
                if (lane == 0) { if (isin) BIASIN[(size_t)(l * 5 + cnd) * NIN + L] = sm; else BIASGU[(size_t)(l * 5 + cnd) * NGU + L] = sm; } }
        }
    }
    GSYNC();

    for (int l = 0; l < 2; ++l) {
        {
            TIDS();
            unsigned char* w = opaque(ws0);
            const bf16_t* CST = (const bf16_t*)(w + WS_CST) + (size_t)l * 1024 * 1536;
            for (int r = gw; r < 1024; r += NGW) {
                const int b = r >> 8, j = r & 255; const size_t kr = (size_t)(NCTX + b * 4352 + j);
#pragma unroll
                for (int t3 = 0; t3 < 3; ++t3) { const int c = t3 * 64 + lane; const u32x4 v = *(const u32x4*)(CST + (size_t)r * 1536 + c * 8);
                    bf16_t* d;
                    if (c < 32) d = (bf16_t*)(w + WS_KA) + kr * 256 + c * 8; else if (c < 64) d = (bf16_t*)(w + WS_VA) + kr * 256 + (c - 32) * 8;
                    else if (c < 128) d = (bf16_t*)(w + WS_KB) + kr * 512 + (c - 64) * 8; else d = (bf16_t*)(w + WS_VB) + kr * 512 + (c - 128) * 8;
                    *(u32x4*)d = v; }
            }
            pg8::Gemm g{(const bf16_t*)(w + WS_XA), (const bf16_t*)(w + WS_WIN) + (size_t)l * NIN * DM, T, NIN, DM}; pg8::StaticOrder S; S.init(T, NIN, G, bid);
            EpiIn E{ws0, out0, l};
            pg8::gemm_phase<EpiIn, pg8::StaticOrder, true, true>(lds, g, S, E);
        }
        GSYNC();
        {
            { unsigned char* w = opaque(ws0);
              pg8::Gemm g{(const bf16_t*)(w + WS_DFTL), (const bf16_t*)(w + WS_FTL), 512, 32768, 512}; pg8::StridedUnits S{bid, G, 256}; EpiFft E{ws0};
              pg8::gemm_phase<EpiFft, pg8::StridedUnits>(lds, g, S, E); }
            { unsigned char* w = opaque(ws0);
              pg8::Gemm g{(const bf16_t*)(w + WS_DFTC), (const bf16_t*)(w + WS_FTC), 256, 16384, 512}; pg8::OneUnit S{bid < 64 ? 1 : 0, 0, bid}; EpiDft E{ws0, 0};
              pg8::gemm_phase<EpiDft, pg8::OneUnit>(lds, g, S, E); }
            __syncthreads();
            LAS unsigned* slot = (LAS unsigned*)(lds + LDSX_OFF + 12288);
            char* attl = (char*)lds_raw;
            for (;;) {
                TIDS();
                const int r32 = lane & 31, hi = lane >> 5;
                unsigned char* w = opaque(ws0);
                if (tid == 0) *slot = atomicAdd((unsigned*)(w + WS_CNT) + 64 * l, 1u);
                __syncthreads();
                const int q = (int)*slot;
                __syncthreads();
                if (q >= 1536) break;
                bf16_t* MIX = (bf16_t*)(w + WS_MIX);
                f32x16 o[4];
                if (q < 512 || (q >= 1024 && q < 1280)) {
                    int tok0, kr0, h, seq;
                    if (q < 512) { const int b = q >> 7; h = (q >> 4) & 7; const int qb = q & 15; tok0 = NCTX + b * 4096 + qb * 256; kr0 = NCTX + b * 4352; seq = 4352; }
                    else { const int qq = q - 1024, b = qq >> 3; h = qq & 7; tok0 = b * 256; kr0 = b * 256; seq = 256; }
                    const bf16_t* Qw = (const bf16_t*)(w + WS_QA) + (size_t)(tok0 + wave * 32 + r32) * 1024 + h * 128 + hi * 8;
                    att::body<8, 256>(Qw, (const bf16_t*)(w + WS_KA) + (size_t)kr0 * 256 + (h >> 2) * 128, (const bf16_t*)(w + WS_VA) + (size_t)kr0 * 256 + (h >> 2) * 128, seq, 0,
                                      0.08838834764831845f * 1.4426950408889634f, attl, o);
#pragma unroll
                    for (int r = 0; r < 16; ++r) { const int orow = tok0 + wave * 32 + att::crow(r, hi);
#pragma unroll
                        for (int d0 = 0; d0 < 4; ++d0) MIX[(size_t)orow * DM + h * 128 + d0 * 32 + r32] = (bf16_t)(cvt_pk_bf16(o[d0][r], 0.f) & 0xffff); }
                } else {
                    int tok0, kr0, hb, seq;
                    if (q < 1024) { const int qq = q - 512, b = qq >> 7; hb = (qq >> 5) & 3; const int qb = qq & 31; tok0 = NCTX + b * 4096 + qb * 128; kr0 = NCTX + b * 4352; seq = 4352; }
                    else { const int qq = q - 1280, b = qq >> 3; hb = (qq >> 1) & 3; const int qb = qq & 1; tok0 = b * 256 + qb * 128; kr0 = b * 256; seq = 256; }
                    const int br = wave >> 2, ws4 = wave & 3;
                    const bf16_t* Qw = (const bf16_t*)(w + WS_QB) + (size_t)(tok0 + ws4 * 32 + r32) * 512 + hb * 128 + br * 64 + hi * 8;
                    att::body<4, 512>(Qw, (const bf16_t*)(w + WS_KB) + (size_t)kr0 * 512 + hb * 128, (const bf16_t*)(w + WS_VB) + (size_t)kr0 * 512 + hb * 128, seq, br * 128,
                                      0.125f * 1.4426950408889634f, attl, o);
                    __syncthreads();
                    LAS float* st = (LAS float*)lds + ws4 * 4096;
                    if (br == 1) {
#pragma unroll
                        for (int d0 = 0; d0 < 4; ++d0)
#pragma unroll
                            for (int r = 0; r < 16; ++r) st[(d0 * 16 + r) * 64 + lane] = o[d0][r];
                    }
                    __syncthreads();
                    if (br == 0) {
                        const float lam = *((const float*)(w + WS_LAM) + l), oml = 1.f - (0.8f - 0.6f * expf(-0.3f * (float)l));
                        float sq[16];
#pragma unroll
                        for (int r = 0; r < 16; ++r) { float sm = 0.f;
#pragma unroll
                            for (int d0 = 0; d0 < 4; ++d0) { const float v = o[d0][r] - lam * st[(d0 * 16 + r) * 64 + lane]; o[d0][r] = v; sm += v * v; }
                            sq[r] = sm; }
#pragma unroll
                        for (int r = 0; r < 16; ++r) { float sm = sq[r];
#pragma unroll
                            for (int off = 1; off < 32; off <<= 1) sm += __shfl_xor(sm, off);
                            sq[r] = rsqrtf(sm * (1.f / 128.f) + EPS) * oml; }
                        const float* sg = (const float*)(w + WS_SMALL) + SP_SUB + l * 128;
                        float gs[4];
#pragma unroll
                        for (int d0 = 0; d0 < 4; ++d0) gs[d0] = sg[d0 * 32 + r32];
#pragma unroll
                        for (int r = 0; r < 16; ++r) { const int orow = tok0 + ws4 * 32 + att::crow(r, hi);
#pragma unroll
                            for (int d0 = 0; d0 < 4; ++d0) MIX[(size_t)orow * DM + 1024 + hb * 128 + d0 * 32 + r32] = (bf16_t)(cvt_pk_bf16(o[d0][r] * sq[r] * gs[d0], 0.f) & 0xffff); }
                    }
                    __syncthreads();
                }
            }
        }
        GSYNC();
        {
            unsigned char* w = opaque(ws0);
            pg8::Gemm g{(const bf16_t*)(w + WS_MIX), (const bf16_t*)(w + WS_WOUT) + (size_t)l * DM * DM, T, DM, DM}; pg8::StaticOrder S; S.init(T, DM, G, bid);
            if (l == 0) { EpiRes<true, false> E{ws0, out0, p.in[0], p.in[1], l * 5 * 12288 + 2 * DM, SP_N2 + l * DM, l * 5 * 12288 + 4 * DM, 2 * l + 1};
                pg8::gemm_phase<EpiRes<true, false>, pg8::StaticOrder, false, true>(lds, g, S, E); }
            else { EpiRes<false, false> E{ws0, out0, nullptr, nullptr, l * 5 * 12288 + 2 * DM, SP_N2 + l * DM, l * 5 * 12288 + 4 * DM, 2 * l + 1};
                pg8::gemm_phase<EpiRes<false, false>, pg8::StaticOrder, false, true>(lds, g, S, E); }
        }
        GSYNC();
        {
            unsigned char* w = opaque(ws0);
            pg8::Gemm g{(const bf16_t*)(w + WS_XA), (const bf16_t*)(w + WS_WGU) + (size_t)l * NGU * DM, T, NGU, DM}; pg8::StaticOrder S; S.init(T, NGU, G, bid);
            EpiGU E{ws0, l};
            pg8::gemm_phase<EpiGU, pg8::StaticOrder, true, true>(lds, g, S, E);
        }
        GSYNC();
        {
            TIDS();
            unsigned char* w = opaque(ws0);
            const float* EDGE = (const float*)(w + WS_EDGE); const float* cw = (const float*)(w + WS_SMALL) + SP_CW + (size_t)l * 3 * DFF; bf16_t* HFF = (bf16_t*)(w + WS_HFF);
            for (long i = gtid; i < 128L * DFF; i += NGT) {
                const int e = (int)(i / DFF), ch = (int)(i % DFF), pml = e >> 1, side = e & 1;
                const bool interior = side == 0 ? ((pml & 15) != 0) : ((pml & 15) != 15);
                if (!interior) continue;
                const float* me = EDGE + (size_t)(e * 3) * DFF;
                const float* ot = EDGE + (size_t)(((side == 0 ? pml - 1 : pml + 1) * 2 + (1 - side)) * 3 + 1) * DFF;
                const float wv = cw[(side == 0 ? 0 : 2) * DFF + ch];
                const float cvv = me[ch] + wv * ot[ch];
                const float h = silu_f(cvv) * me[2 * DFF + ch];
                const int row = NCTX + pml * 256 + (side ? 255 : 0);
                HFF[blk(row, ch, 88)] = (bf16_t)(cvt_pk_bf16(h, 0.f) & 0xffff);
            }
        }
        GSYNC();
        {
            unsigned char* w = opaque(ws0);
            pg8::Gemm g{(const bf16_t*)(w + WS_HFF), (const bf16_t*)(w + WS_WDN) + (size_t)l * DM * DFF, T, DM, DFF}; pg8::StaticOrder S; S.init(T, DM, G, bid);
            if (l == 0) { EpiRes<false, false> E{ws0, out0, nullptr, nullptr, l * 5 * 12288 + 5 * DM, SP_N1 + DM, 5 * 12288 + 1 * DM, 2 * l + 2};
                pg8::gemm_phase<EpiRes<false, false>, pg8::StaticOrder, true, true>(lds, g, S, E); }
            else if (G == 256) { EpiRes<false, true> E{ws0, out0, nullptr, nullptr, l * 5 * 12288 + 5 * DM, SP_FIN, 0, 2 * l + 2}; pg8::PanelOrder SP{bid, G};
                pg8::gemm_phase<EpiRes<false, true>, pg8::PanelOrder, true, true>(lds, g, SP, E); }
            else { EpiRes<false, false, true> E{ws0, out0, nullptr, nullptr, l * 5 * 12288 + 5 * DM, -1, 5 * 12288 + 1 * DM, 2 * l + 2};
                pg8::gemm_phase<EpiRes<false, false, true>, pg8::StaticOrder, true, true>(lds, g, S, E); }
        }
        if (l == 0 || G != 256) GSYNC();
    }
    if (G != 256) {
        TIDS();
        unsigned char* w = opaque(ws0); float* X = opaque(out0);
        const float* SS = (const float*)(w + WS_SS) + (size_t)4 * T; const float* fin_g = (const float*)(w + WS_SMALL) + SP_FIN;
        for (int row = gw; row < T; row += NGW) {
            const float rs = rsqrtf(SS[row] * (1.f / DM) + EPS);
            float* xr = X + (size_t)row * DM;
#pragma unroll
            for (int j = 0; j < 8; ++j) { const int c = j * 256 + lane * 4; const f32x4 x = *(const f32x4*)(xr + c); *(f32x4*)(xr + c) = x * rs * *(const f32x4*)(fin_g + c); }
        }
    }
}

extern "C" void kernel_launch(void* const* d_in, const int* in_sizes, int n_in, void* d_out, int out_size, void* d_ws, size_t ws_size, hipStream_t stream) {
    static int grid_blocks = 0;
    if (grid_blocks == 0) {
        int dev = 0, cus = 0, per_cu = 0;
        if (n_in != 27 || ws_size < WS_END) { fprintf(stderr, "kernel_launch: n_in %d ws %zu (need %zu)\n", n_in, ws_size, (size_t)WS_END); grid_blocks = -1; return; }
        (void)hipGetDevice(&dev);
        (void)hipDeviceGetAttribute(&cus, hipDeviceAttributeMultiprocessorCount, dev);
        (void)hipFuncSetAttribute((const void*)fwd_megakernel, hipFuncAttributeMaxDynamicSharedMemorySize, LDS_BYTES);
        (void)hipOccupancyMaxActiveBlocksPerMultiprocessor(&per_cu, (const void*)fwd_megakernel, 512, LDS_BYTES);
        (void)hipGetLastError();
        grid_blocks = cus > 0 ? cus : 256;
        fprintf(stderr, "kernel_launch: cus %d per_cu %d grid %d ws %zu\n", cus, per_cu, grid_blocks, ws_size);
    }
    if (grid_blocks < 0) return;
    Params p{};
    for (int i = 0; i < 27; ++i) p.in[i] = (const float*)d_in[i];
    p.out = (float*)d_out; p.ws = (unsigned char*)d_ws;
    void* args[] = {&p};
    hipError_t e = hipLaunchCooperativeKernel((const void*)fwd_megakernel, dim3(grid_blocks), dim3(512), args, LDS_BYTES, stream);
    if (e != hipSuccess) fprintf(stderr, "cooperative launch failed: %s (grid %d)\n", hipGetErrorString(e), grid_blocks);
}
```

```cpp
#include <hip/hip_runtime.h>
#include <hip/hip_cooperative_groups.h>
#include <cstdio>
#include <cstdint>
namespace cg = cooperative_groups;

#define LAS __attribute__((address_space(3)))
typedef unsigned short bf16_t;
typedef short bf16x8 __attribute__((ext_vector_type(8)));
typedef short s16x4 __attribute__((ext_vector_type(4)));
typedef float f32x4 __attribute__((ext_vector_type(4)));
typedef float f32x16 __attribute__((ext_vector_type(16)));
typedef unsigned u32x4 __attribute__((ext_vector_type(4)));
typedef unsigned u32x2 __attribute__((ext_vector_type(2)));

constexpr int DM = 2048, NCTX = 8192, NLAT = 16384, T = NCTX + NLAT, DFF = 5632, NGU = 2 * DFF, NIN = 4096, DIN = 3584;
constexpr int KVROWS = NCTX + 4 * 4352;
constexpr float EPS = 1e-6f;
constexpr size_t MiB = 1u << 20;
constexpr size_t WS_CTL = 0;
constexpr size_t CTL_BYTES = 1 * MiB;
constexpr size_t WS_SS = 0;
constexpr size_t WS_CNT = 512 * 1024;
constexpr size_t WS_BAR = 512 * 1024 + 65536;
constexpr size_t WS_MOD = 1 * MiB;
constexpr size_t WS_BIASIN = 2 * MiB;
constexpr size_t WS_BIASGU = 2 * MiB + 512 * 1024;
constexpr size_t WS_ROPE = 3 * MiB;
constexpr size_t WS_LAM = 3 * MiB + 64 * 1024;
constexpr size_t WS_EDGE = 4 * MiB;
constexpr size_t WS_DFTC = 13 * MiB;
constexpr size_t WS_DFTL = 14 * MiB;
constexpr size_t WS_WIN = 78 * MiB;
constexpr size_t WS_WOUT = 110 * MiB;
constexpr size_t WS_WGU = 126 * MiB;
constexpr size_t WS_WDN = 214 * MiB;
constexpr size_t WS_XA = 258 * MiB;
constexpr size_t WS_QA = 354 * MiB;
constexpr size_t WS_QB = 402 * MiB;
constexpr size_t WS_KA = 426 * MiB;
constexpr size_t WS_VA = 439 * MiB;
constexpr size_t WS_KB = 452 * MiB;
constexpr size_t WS_VB = 477 * MiB;
constexpr size_t WS_FTC = 502 * MiB;
constexpr size_t WS_FTL = 518 * MiB;
constexpr size_t WS_MIX = 550 * MiB;
constexpr size_t WS_HFF = 354 * MiB;
constexpr size_t WS_CST = 646 * MiB;
constexpr size_t WS_X16 = 652 * MiB;
constexpr size_t WS_END = 748 * MiB;
constexpr size_t WS_SMALL = 3 * MiB + 128 * 1024;
constexpr int SP_N1 = 0, SP_N2 = 4096, SP_QN = 8192, SP_KN = 8448, SP_SUB = 8704, SP_FIN = 8960, SP_CB = 11008, SP_CW = 22272, SP_END = 56064;
constexpr size_t O_Y = 0, O_K = (size_t)T * DM, O_V = O_K + 4194304, O_DK = O_V + 4194304, O_DV = O_DK + 8388608;
constexpr int RING_BYTES = 131072, LDSX_OFF = 131072, LDS_BYTES = 147456;

struct Params {
    const float* in[27];
    float* out;
    unsigned char* ws;
};

__device__ __forceinline__ unsigned cvt_pk_bf16(float lo, float hi) { unsigned r; asm volatile("v_cvt_pk_bf16_f32 %0, %1, %2" : "=v"(r) : "v"(lo), "v"(hi)); return r; }
__device__ __forceinline__ u32x4 pack8(f32x4 a, f32x4 b) { u32x4 w; w.x = cvt_pk_bf16(a[0], a[1]); w.y = cvt_pk_bf16(a[2], a[3]); w.z = cvt_pk_bf16(b[0], b[1]); w.w = cvt_pk_bf16(b[2], b[3]); return w; }
__device__ __forceinline__ float silu_f(float x) { return x * __builtin_amdgcn_rcpf(1.f + __expf(-x)); }
__device__ __forceinline__ float wave_sum(float v) {
#pragma unroll
    for (int o = 1; o < 64; o <<= 1) v += __shfl_xor(v, o);
    return v;
}
#define LDS_WAIT() asm volatile("s_waitcnt lgkmcnt(0)" ::: "memory")
__device__ __forceinline__ unsigned char* opaque(unsigned char* p) { size_t z; asm volatile("s_mov_b64 %0, 0" : "=s"(z)); return p + z; }
__device__ __forceinline__ float* opaque(float* p) { size_t z; asm volatile("s_mov_b64 %0, 0" : "=s"(z)); return p + z; }

__device__ __forceinline__ size_t blk(int row, int col, int nt) { return ((size_t)((row >> 8) * nt + (col >> 6)) << 14) + (size_t)(((row & 255) << 6) + (col & 63)); }
__device__ __forceinline__ int win_srccol(int L) {
    if (L < 1280) {
        const int base = L & ~127, Lh = L & 127, wc = Lh >> 5, fq = (Lh >> 3) & 3, n = (Lh >> 2) & 1, i = Lh & 3;
        const int pi = 16 * wc + 4 * fq + i; return base + (pi < 32 ? pi : pi + 32) + 32 * n;
    }
    if (L >= 1536 && L < 2560) {
        const int base = L & ~63, Ls = L & 63, w1 = Ls >> 5, fq = (Ls >> 3) & 3, n = (Ls >> 2) & 1, i = Ls & 3;
        const int pi = 16 * w1 + 4 * fq + i; return base + (pi < 16 ? pi : pi + 16) + 16 * n;
    }
    return L;
}

namespace pg8 {
constexpr int BM = 256, BK = 64, HALF = 128, HTB = HALF * BK * 2, NXCD = 8, WGM = 4;
__host__ __device__ __forceinline__ int lds_byte(int r, int c) { const int st = (r >> 4) * 2 + (c >> 5), rr = r & 15, cc = c & 31, ob = rr * 64 + cc * 2; return st * 1024 + (ob ^ (((ob >> 9) & 1) << 5)); }
__host__ __device__ __forceinline__ void stage_rc(int b, int& R, int& C) { const int st = b / 1024, sb = b % 1024, swz = sb ^ (((sb >> 9) & 1) << 5); R = (st >> 1) * 16 + swz / 64; C = (st & 1) * 32 + (swz % 64) / 2; }
__host__ __device__ __forceinline__ int perm32(int rho) { const int n = rho >> 4, i = rho & 15; return 8 * (i >> 2) + 4 * n + (i & 3); }
struct Unit { int pm, pn; };
struct Gemm { const bf16_t* A; const bf16_t* Bt; int M, N, K; };
struct StaticOrder {
    int nM, nN, nwg, G, c;
    __device__ void init(int M, int N, int G_, int c_) { nM = M / BM; nN = N / BM; nwg = nM * nN; G = G_; c = c_; }
    __device__ bool next(int i, Unit& u) const {
        const long L = (long)i * G + c; if (L >= nwg) return false;
        int wgid = (int)L; { const int q = nwg / NXCD, r = nwg % NXCD, xcd = wgid % NXCD, off = wgid / NXCD; wgid = (xcd < r ? xcd * (q + 1) : r * (q + 1) + (xcd - r) * q) + off; }
        const int nig = WGM * nN, gid = wgid / nig, fm = gid * WGM, gsz = (nM - fm) < WGM ? (nM - fm) : WGM;
        u.pm = fm + ((wgid % nig) % gsz); u.pn = (wgid % nig) / gsz; return true;
    }
};
struct StridedUnits {
    int c, G, total;
    __device__ bool next(int i, Unit& u) const { const int v = c + i * G; if (v >= total) return false; u.pm = v & 1; u.pn = v >> 1; return true; }
};
struct PanelOrder {
    int c, G;
    __device__ bool next(int i, Unit& u) const { if (G != 256 || i >= 3) return false; const int x = c & 7, j = c >> 3; u.pm = (i * 8 + x) * 4 + (j >> 3); u.pn = j & 7; return true; }
};
struct OneUnit {
    int have, pm, pn;
    __device__ bool next(int i, Unit& u) const { if (i > 0 || !have) return false; u.pm = pm; u.pn = pn; return true; }
};

template <class Epi, class Sched, bool ABLK = false, bool BBLK = false>
__device__ __forceinline__ void gemm_phase(LAS unsigned char* lds, const Gemm g, const Sched& S, const Epi& E) {
    int tid = threadIdx.x; asm volatile("" : "+v"(tid));
    const int wid = __builtin_amdgcn_readfirstlane(tid >> 6), lane = tid & 63, wr = wid >> 2, wc = wid & 3, fr = lane & 15, fq = lane >> 4;
    const int K = g.K, nt = K / BK;
    unsigned voffA[2], voffB[2];
#pragma unroll
    for (int i = 0; i < 2; ++i) { int R, C; stage_rc(tid * 16 + i * 8192, R, C); const int Rb = (R & ~31) + perm32(R & 31);
        voffA[i] = ABLK ? (unsigned)(R * 64 + C) * 2u : (unsigned)(R * K + C) * 2u; voffB[i] = BBLK ? (unsigned)(Rb * 64 + C) * 2u : (unsigned)(Rb * K + C) * 2u; }
    const size_t kstepA = ABLK ? (size_t)32768 : (size_t)(BK * 2), kstepB = BBLK ? (size_t)32768 : (size_t)(BK * 2);
    const size_t hstepA = ABLK ? (size_t)16384 : (size_t)HALF * K * 2, hstepB = BBLK ? (size_t)16384 : (size_t)HALF * K * 2;
    const size_t tstepA = (size_t)2 * HALF * K * 2, tstepB = tstepA;
    const unsigned ldsw = (unsigned)wid * 1024u;
    const int aoff = lds_byte(wr * 64 + fr, fq * 8), boff = lds_byte(wc * 32 + fr, fq * 8);
#define PG8_SA(b, h) (((b) * 2 + (h)) * HTB)
#define PG8_SB(b, h) ((4 + (b) * 2 + (h)) * HTB)
#define PG8_STAGE(bufoff, gbase, voff) do { _Pragma("unroll") for (int _i = 0; _i < 2; ++_i) \
        __builtin_amdgcn_global_load_lds((const unsigned*)((const char*)(gbase) + (voff)[_i]), (LAS unsigned*)(lds + (bufoff) + ldsw + _i * 8192), 16, 0, 0); } while (0)
#define PG8_LDA(dst, b, h) do { _Pragma("unroll") for (int m = 0; m < 4; ++m) _Pragma("unroll") for (int k = 0; k < 2; ++k) dst[m][k] = *(const LAS bf16x8*)(lds + PG8_SA(b, h) + aoff + m * 2048 + k * 1024); } while (0)
#define PG8_LDB(dst, b, h) do { _Pragma("unroll") for (int n = 0; n < 2; ++n) _Pragma("unroll") for (int k = 0; k < 2; ++k) dst[n][k] = *(const LAS bf16x8*)(lds + PG8_SB(b, h) + boff + n * 2048 + k * 1024); } while (0)
#define PG8_MMA(ai, bj, At, Bt) do { __builtin_amdgcn_s_setprio(1); _Pragma("unroll") for (int m = 0; m < 4; ++m) _Pragma("unroll") for (int n = 0; n < 2; ++n) _Pragma("unroll") for (int k = 0; k < 2; ++k) \
        acc[ai][bj][m][n] = __builtin_amdgcn_mfma_f32_16x16x32_bf16(Bt[n][k], At[m][k], acc[ai][bj][m][n], 0, 0, 0); __builtin_amdgcn_s_setprio(0); } while (0)
#define PG8_WAIT_V(n) asm volatile("s_waitcnt vmcnt(" #n ")" ::: "memory")
#define PG8_WAIT_L(n) asm volatile("s_waitcnt lgkmcnt(" #n ")" ::: "memory")
#define PG8_BAR __builtin_amdgcn_s_barrier()
#define PG8_SCHED __builtin_amdgcn_sched_barrier(0)
    Unit cur, nxt; int ui = 0;
    if (!S.next(0, cur)) return;
    f32x4 acc[2][2][4][2];
#pragma unroll
    for (int a = 0; a < 2; ++a)
#pragma unroll
        for (int b = 0; b < 2; ++b)
#pragma unroll
            for (int m = 0; m < 4; ++m)
#pragma unroll
                for (int n = 0; n < 2; ++n) acc[a][b][m][n] = (f32x4){0.f, 0.f, 0.f, 0.f};
    bf16x8 At[4][2], B0[2][2], B1[2][2];
    const char* cA = (const char*)g.A + (size_t)cur.pm * tstepA; const char* cB = (const char*)g.Bt + (size_t)cur.pn * tstepB;
    PG8_STAGE(PG8_SB(0, 0), cB, voffB); PG8_STAGE(PG8_SB(0, 1), cB + hstepB, voffB); PG8_STAGE(PG8_SA(0, 0), cA, voffA); PG8_STAGE(PG8_SA(0, 1), cA + hstepA, voffA);
    if (wr == 1) PG8_BAR;
    PG8_WAIT_V(2); PG8_BAR;
    PG8_STAGE(PG8_SB(1, 0), cB + kstepB, voffB); PG8_STAGE(PG8_SA(1, 0), cA + kstepA, voffA); PG8_STAGE(PG8_SB(1, 1), cB + hstepB + kstepB, voffB);
    PG8_WAIT_V(6); PG8_BAR;
    for (;;) {
        const bool has_next = S.next(ui + 1, nxt);
        const char* nA = has_next ? (const char*)g.A + (size_t)nxt.pm * tstepA : cA; const char* nB = has_next ? (const char*)g.Bt + (size_t)nxt.pn * tstepB : cB;
        for (int t = 0; t < nt; t += 2) {
            const bool last = (t == nt - 2);
            const char* a1 = cA + (size_t)(t + 1) * kstepA;
            const char* a2 = last ? nA : cA + (size_t)(t + 2) * kstepA; const char* b2 = last ? nB : cB + (size_t)(t + 2) * kstepB;
            const char* a3 = a2 + kstepA; const char* b3 = b2 + kstepB;
            PG8_LDB(B0, 0, 0); PG8_LDB(B1, 0, 1); PG8_SCHED; PG8_LDA(At, 0, 0); PG8_STAGE(PG8_SA(1, 1), a1 + hstepA, voffA);
            PG8_WAIT_V(8); PG8_WAIT_L(0); PG8_BAR; PG8_MMA(0, 0, At, B0); PG8_MMA(0, 1, At, B1); PG8_BAR; PG8_SCHED;
            PG8_LDA(At, 0, 1); PG8_STAGE(PG8_SB(0, 0), b2, voffB); PG8_STAGE(PG8_SB(0, 1), b2 + hstepB, voffB); PG8_STAGE(PG8_SA(0, 0), a2, voffA);
            PG8_WAIT_V(8); PG8_WAIT_L(0); PG8_BAR; PG8_MMA(1, 0, At, B0); PG8_MMA(1, 1, At, B1); PG8_BAR; PG8_SCHED;
            PG8_LDB(B0, 1, 0); PG8_LDB(B1, 1, 1); PG8_SCHED; PG8_LDA(At, 1, 0); PG8_STAGE(PG8_SA(0, 1), a2 + hstepA, voffA);
            PG8_WAIT_V(8); PG8_WAIT_L(0); PG8_BAR; PG8_MMA(0, 0, At, B0); PG8_MMA(0, 1, At, B1); PG8_BAR; PG8_SCHED;
            PG8_LDA(At, 1, 1); PG8_STAGE(PG8_SB(1, 0), b3, voffB); PG8_STAGE(PG8_SB(1, 1), b3 + hstepB, voffB); PG8_STAGE(PG8_SA(1, 0), a3, voffA);
            PG8_WAIT_V(8); PG8_WAIT_L(0); PG8_BAR; PG8_MMA(1, 0, At, B0); PG8_MMA(1, 1, At, B1); PG8_BAR; PG8_SCHED;
        }
        if (wr == 0) PG8_BAR;
        { int ln = threadIdx.x; asm volatile("" : "+v"(ln)); ln &= 63; E(acc, cur, wr, wc, ln & 15, ln >> 4, lds + LDSX_OFF, ln); }
        if (!has_next) break;
#pragma unroll
        for (int a = 0; a < 2; ++a)
#pragma unroll
            for (int b = 0; b < 2; ++b)
#pragma unroll
                for (int m = 0; m < 4; ++m)
#pragma unroll
                    for (int n = 0; n < 2; ++n) acc[a][b][m][n] = (f32x4){0.f, 0.f, 0.f, 0.f};
        cur = nxt; cA = nA; cB = nB; ++ui;
        if (wr == 1) PG8_BAR;
    }
    PG8_WAIT_V(0);
    PG8_BAR;
#undef PG8_SA
#undef PG8_SB
#undef PG8_STAGE
#undef PG8_LDA
#undef PG8_LDB
#undef PG8_MMA
#undef PG8_WAIT_V
#undef PG8_WAIT_L
#undef PG8_BAR
#undef PG8_SCHED
}
}
using pg8::Unit;

__device__ __forceinline__ int kvrow_of(int row) { return row < NCTX ? row : NCTX + ((row - NCTX) >> 12) * 4352 + 256 + ((row - NCTX) & 4095); }

struct EpiIn {
    unsigned char* ws_; float* out_; int l;
    __device__ __forceinline__ void operator()(f32x4 (&acc)[2][2][4][2], const Unit& u, int wr, int wc, int fr, int fq, LAS unsigned char* ldsx, int lane) const {
        unsigned char* w = opaque(ws_);
        const float* ss = (const float*)(w + WS_SS) + (size_t)(2 * l) * T;
        const float* bias = (const float*)(w + WS_BIASIN) + (size_t)l * 5 * NIN;
        const int pm = u.pm, pn = u.pn; const bool lat = pm >= 32; const int cond = lat ? 1 + ((pm - 32) >> 4) : 0;
        const int cl = wc * 32 + 8 * fq;
        {
            f32x4 bv[2][2];
#pragma unroll
            for (int bj = 0; bj < 2; ++bj)
#pragma unroll
                for (int n = 0; n < 2; ++n) bv[bj][n] = *(const f32x4*)(bias + cond * NIN + pn * 256 + bj * 128 + cl + 4 * n);
#pragma unroll
            for (int ai = 0; ai < 2; ++ai)
#pragma unroll
                for (int m = 0; m < 4; ++m) { const int row = pm * 256 + ai * 128 + wr * 64 + m * 16 + fr; const float rs = rsqrtf(ss[row] * (1.f / DM) + EPS);
#pragma unroll
                    for (int bj = 0; bj < 2; ++bj)
#pragma unroll
                        for (int n = 0; n < 2; ++n) acc[ai][bj][m][n] = acc[ai][bj][m][n] * rs + bv[bj][n]; }
        }
        if (pn <= 4) {
            LAS float* P = (LAS float*)ldsx;
#pragma unroll
            for (int ai = 0; ai < 2; ++ai)
#pragma unroll
                for (int m = 0; m < 4; ++m)
#pragma unroll
                    for (int bj = 0; bj < 2; ++bj) { const f32x4 a = acc[ai][bj][m][0], b = acc[ai][bj][m][1];
                        float s = (a[0] * a[0] + a[1] * a[1]) + (a[2] * a[2] + a[3] * a[3]) + (b[0] * b[0] + b[1] * b[1]) + (b[2] * b[2] + b[3] * b[3]);
                        s += __shfl_xor(s, 16); s += __shfl_xor(s, 32);
                        if (fq == 0) P[((ai * 128 + wr * 64 + m * 16 + fr) * 2 + bj) * 4 + wc] = s; }
            LDS_WAIT(); __builtin_amdgcn_s_barrier(); asm volatile("" ::: "memory");
            const bool isk = (pn == 4);
            const float* gg = (const float*)(w + WS_SMALL) + (isk ? SP_KN : SP_QN) + l * 128;
            const float* rope = (const float*)(w + WS_ROPE);
            bf16_t* QA = (bf16_t*)(w + WS_QA); bf16_t* KA = (bf16_t*)(w + WS_KA); float* oK = opaque(out_) + O_K;
            const int pb = (wc < 2) ? (16 * wc + 4 * fq) : (16 * wc + 4 * fq + 32);
            const f32x4 g0 = *(const f32x4*)(gg + pb), g1 = *(const f32x4*)(gg + pb + 32);
            const int j0 = (16 * wc + 4 * fq) & 31;
#pragma unroll
            for (int ai = 0; ai < 2; ++ai)
#pragma unroll
                for (int m = 0; m < 4; ++m) { const int rt = ai * 128 + wr * 64 + m * 16 + fr, row = pm * 256 + rt;
                    f32x4 cs = (f32x4){1.f, 1.f, 1.f, 1.f}, sn = (f32x4){0.f, 0.f, 0.f, 0.f};
                    if (lat) { const int nt_ = (row - NCTX) & 4095; const int pos = (wc < 2) ? (nt_ >> 6) : (nt_ & 63);
                        cs = *(const f32x4*)(rope + pos * 32 + j0); sn = *(const f32x4*)(rope + 2048 + pos * 32 + j0); }
#pragma unroll
                    for (int bj = 0; bj < 2; ++bj) {
                        const f32x4 pp = *(const LAS f32x4*)(P + (rt * 2 + bj) * 4);
                        const float rh = rsqrtf(((pp[0] + pp[1]) + (pp[2] + pp[3])) * (1.f / 128.f) + EPS);
                        const f32x4 v0 = acc[ai][bj][m][0] * rh * g0, v1 = acc[ai][bj][m][1] * rh * g1;
                        const f32x4 o0 = v0 * cs - v1 * sn, o1 = v1 * cs + v0 * sn;
                        const float qsc = isk ? 1.f : 0.08838834764831845f * 1.4426950408889634f;
                        const u32x4 wv = pack8(o0 * qsc, o1 * qsc);
                        if (!isk) *(u32x4*)(QA + (size_t)row * 1024 + pn * 256 + bj * 128 + cl) = wv;
                        else { *(u32x4*)(KA + (size_t)kvrow_of(row) * 256 + bj * 128 + cl) = wv;
                            if (!lat) { float* o = oK + ((size_t)((pm * 2 + l) * 256 + rt)) * 256 + bj * 128 + pb; *(f32x4*)o = v0; *(f32x4*)(o + 32) = v1; } }
                    } }
        } else if (pn == 5 || pn == 10 || pn == 11) {
            const bool isa = (pn == 5); const int ld = isa ? 256 : 512; const int cb = isa ? 0 : (pn - 10) * 256;
            bf16_t* dst = (bf16_t*)(w + (isa ? WS_VA : WS_VB)); float* od = opaque(out_) + (isa ? O_V : O_DV);
#pragma unroll
            for (int ai = 0; ai < 2; ++ai)
#pragma unroll
                for (int m = 0; m < 4; ++m) { const int rt = ai * 128 + wr * 64 + m * 16 + fr, row = pm * 256 + rt; const size_t kr = (size_t)kvrow_of(row);
#pragma unroll
                    for (int bj = 0; bj < 2; ++bj) { const f32x4 v0 = acc[ai][bj][m][0], v1 = acc[ai][bj][m][1];
                        *(u32x4*)(dst + kr * ld + cb + bj * 128 + cl) = pack8(v0, v1);
                        if (!lat) { float* o = od + ((size_t)((pm * 2 + l) * 256 + rt)) * ld + cb + bj * 128 + cl; *(f32x4*)o = v0; *(f32x4*)(o + 4) = v1; } } }
        } else if (pn >= 6 && pn <= 9) {
            const bool isk = pn >= 8; const int cb = (pn & 1) * 256;
            const int w1 = wc & 1, pi0 = 16 * w1 + 4 * fq, pb = w1 ? pi0 + 16 : pi0, j0 = pi0 & 15;
            const float* rb = (const float*)(w + WS_ROPE) + 4096;
            bf16_t* QB = (bf16_t*)(w + WS_QB); bf16_t* KB = (bf16_t*)(w + WS_KB); float* oDK = opaque(out_) + O_DK;
#pragma unroll
            for (int ai = 0; ai < 2; ++ai)
#pragma unroll
                for (int m = 0; m < 4; ++m) { const int rt = ai * 128 + wr * 64 + m * 16 + fr, row = pm * 256 + rt;
                    f32x4 cs = (f32x4){1.f, 1.f, 1.f, 1.f}, sn = (f32x4){0.f, 0.f, 0.f, 0.f};
                    if (lat) { const int nt_ = (row - NCTX) & 4095; const int pos = w1 ? (nt_ & 63) : (nt_ >> 6);
                        cs = *(const f32x4*)(rb + pos * 16 + j0); sn = *(const f32x4*)(rb + 1024 + pos * 16 + j0); }
#pragma unroll
                    for (int bj = 0; bj < 2; ++bj) { const f32x4 v0 = acc[ai][bj][m][0], v1 = acc[ai][bj][m][1];
                        const f32x4 o0 = v0 * cs - v1 * sn, o1 = v1 * cs + v0 * sn;
                        const float qsc = isk ? 1.f : 0.125f * 1.4426950408889634f;
                        const u32x4 wv = pack8(o0 * qsc, o1 * qsc);
                        if (!isk) *(u32x4*)(QB + (size_t)row * 512 + cb + bj * 128 + cl) = wv;
                        else { *(u32x4*)(KB + (size_t)kvrow_of(row) * 512 + cb + bj * 128 + cl) = wv;
                            if (!lat) { float* o = oDK + ((size_t)((pm * 2 + l) * 256 + rt)) * 512 + cb + bj * 128 + (wc >> 1) * 64 + pb; *(f32x4*)o = v0; *(f32x4*)(o + 16) = v1; } }
                    } }
        } else {
            const int cs_ = (pn - 12) >> 1, cm0 = ((pn - 12) & 1) * 256 + cl;
            bf16_t* FTC = (bf16_t*)(w + WS_FTC); bf16_t* FTL = (bf16_t*)(w + WS_FTL);
            if (lat) {
                const int b = (pm - 32) >> 4, n2 = fr;
#pragma unroll
                for (int ai = 0; ai < 2; ++ai) { const int n1 = ((pm - 32) & 15) * 16 + ai * 8 + wr * 4;
                    bf16_t* base = FTL + (size_t)(128 * (n2 >> 3) + (n2 & 7)) * 512 + cs_ * 256 + n1;
#pragma unroll
                    for (int bj = 0; bj < 2; ++bj)
#pragma unroll
                        for (int n = 0; n < 2; ++n) { const int colid = b * 512 + cm0 + bj * 128 + 4 * n;
                            bf16_t* q = base + (size_t)((colid >> 4) * 256 + 32 * ((colid & 15) >> 2)) * 512;
#pragma unroll
                            for (int i = 0; i < 4; ++i) { u32x2 o; o.x = cvt_pk_bf16(acc[ai][bj][0][n][i], acc[ai][bj][1][n][i]); o.y = cvt_pk_bf16(acc[ai][bj][2][n][i], acc[ai][bj][3][n][i]);
                                *(u32x2*)(q + (size_t)(8 * i) * 512) = o; } } }
            } else {
#pragma unroll
                for (int ai = 0; ai < 2; ++ai)
#pragma unroll
                    for (int m = 0; m < 4; ++m) { const int rt = ai * 128 + wr * 64 + m * 16 + fr;
                        bf16_t* base = FTC + (size_t)pm * 512 * 512 + cs_ * 256 + rt; const size_t ld = 512;
#pragma unroll
                        for (int bj = 0; bj < 2; ++bj)
#pragma unroll
                            for (int n = 0; n < 2; ++n) { const f32x4 v = acc[ai][bj][m][n];
                                const unsigned p0 = cvt_pk_bf16(v[0], v[1]), p1 = cvt_pk_bf16(v[2], v[3]);
                                bf16_t* q = base + (size_t)(cm0 + bj * 128 + 4 * n) * ld;
                                q[0] = (bf16_t)(p0 & 0xffff); q[ld] = (bf16_t)(p0 >> 16); q[2 * ld] = (bf16_t)(p1 & 0xffff); q[3 * ld] = (bf16_t)(p1 >> 16); } }
            }
        }
    }
};

struct EpiDft {
    unsigned char* ws_; int lat;
    __device__ __forceinline__ void operator()(f32x4 (&acc)[2][2][4][2], const Unit& u, int wr, int wc, int fr, int fq, LAS unsigned char* ldsx, int lane) const {
        bf16_t* MIX = (bf16_t*)(opaque(ws_) + WS_MIX);
        const int cl = 1536 + (u.pn & 1) * 256 + wc * 32 + 8 * fq;
        const int tok0 = lat ? NCTX + (u.pn >> 1) * 4096 + u.pm * 256 : (u.pn >> 1) * 256;
#pragma unroll
        for (int ai = 0; ai < 2; ++ai)
#pragma unroll
            for (int m = 0; m < 4; ++m) { const int row = tok0 + ai * 128 + wr * 64 + m * 16 + fr;
#pragma unroll
                for (int bj = 0; bj < 2; ++bj) *(u32x4*)(MIX + (size_t)row * DM + cl + bj * 128) = pack8(acc[ai][bj][m][0], acc[ai][bj][m][1]); }
    }
};

struct EpiFft {
    unsigned char* ws_;
    __device__ __forceinline__ void operator()(f32x4 (&acc)[2][2][4][2], const Unit& u, int wr, int wc, int fr, int fq, LAS unsigned char* ldsx, int lane) const {
        bf16_t* MIX = (bf16_t*)(opaque(ws_) + WS_MIX);
        constexpr float C16[16] = {1.f, 0.9238795325112867f, 0.7071067811865476f, 0.3826834323650898f, 0.f, -0.3826834323650898f, -0.7071067811865476f, -0.9238795325112867f,
                                   -1.f, -0.9238795325112867f, -0.7071067811865476f, -0.3826834323650898f, 0.f, 0.3826834323650898f, 0.7071067811865476f, 0.9238795325112867f};
        const int colid = u.pn * 16 + wc * 4 + fq, b = colid >> 9, cm = colid & 511;
#pragma unroll
        for (int m = 0; m < 4; ++m) {
            const int k1 = u.pm * 128 + wr * 64 + m * 16 + fr;
            float yr[16], yi[16];
#pragma unroll
            for (int n2 = 0; n2 < 16; ++n2) { const float ar = acc[0][n2 >> 3][m][(n2 >> 2) & 1][n2 & 3], ai_ = acc[1][n2 >> 3][m][(n2 >> 2) & 1][n2 & 3];
                const float ph = (float)((n2 * k1) & 4095) * (1.f / 4096.f); const float c = __builtin_amdgcn_cosf(ph), sn = __builtin_amdgcn_sinf(ph);
                yr[n2] = c * ar + sn * ai_; yi[n2] = c * ai_ - sn * ar; }
#pragma unroll
            for (int k2 = 0; k2 < 16; ++k2) { float z = 0.f;
#pragma unroll
                for (int n2 = 0; n2 < 16; ++n2) z += C16[(n2 * k2) & 15] * yr[n2] + C16[(n2 * k2 + 12) & 15] * yi[n2];
                MIX[(size_t)(NCTX + b * 4096 + k1 + 256 * k2) * DM + 1536 + cm] = (bf16_t)(cvt_pk_bf16(z, 0.f) & 0xffff); }
        }
    }
};

constexpr size_t WS_PCNT = 512 * 1024 + 8192;
template <bool FROM_IN, bool FINAL, bool OUTF32 = false>
struct EpiRes {
    unsigned char* ws_; float* out_; const float* xin_c; const float* xin_l; int gate_off  ; int ng_off  ; int nsc_off  ; int ss_idx;
    __device__ __forceinline__ void operator()(f32x4 (&acc)[2][2][4][2], const Unit& u, int wr, int wc, int fr, int fq, LAS unsigned char* ldsx, int lane) const {
        unsigned char* w = opaque(ws_); float* Y = opaque(out_);
        const float* gate = (const float*)(w + WS_MOD) + gate_off; const float* nsc = (const float*)(w + WS_MOD) + nsc_off;
        const float* ng = (const float*)(w + WS_SMALL) + ng_off; const bool hasn = ng_off >= 0;
        bf16_t* XA = (bf16_t*)(w + WS_XA); bf16_t* X16 = (bf16_t*)(w + WS_X16); float* ssn = (float*)(w + WS_SS) + (size_t)ss_idx * T;
        const int pm = u.pm, pn = u.pn; const int cond = pm >= 32 ? 1 + ((pm - 32) >> 4) : 0;
        const int c0 = pn * 256 + wc * 32 + 8 * fq;
        f32x4 gv[2][2], gm[2][2];
#pragma unroll
        for (int bj = 0; bj < 2; ++bj)
#pragma unroll
            for (int n = 0; n < 2; ++n) { const int c = c0 + bj * 128 + 4 * n; gv[bj][n] = *(const f32x4*)(gate + cond * 12288 + c);
                if (FINAL) gm[bj][n] = *(const f32x4*)(ng + c);
                else if (hasn) gm[bj][n] = *(const f32x4*)(ng + c) * (*(const f32x4*)(nsc + cond * 12288 + c) + 1.f); else gm[bj][n] = (f32x4){0.f, 0.f, 0.f, 0.f}; }
#pragma unroll
        for (int ai = 0; ai < 2; ++ai)
#pragma unroll
            for (int m = 0; m < 4; ++m) { const int row = pm * 256 + ai * 128 + wr * 64 + m * 16 + fr;
                bf16_t* xb = X16 + (size_t)row * DM + c0; float s = 0.f;
                const float* xi = (row < NCTX ? xin_c + (size_t)row * DM : xin_l + (size_t)(row - NCTX) * DM) + c0;
#pragma unroll
                for (int bj = 0; bj < 2; ++bj) {
                    f32x4 x0, x1;
                    if (FROM_IN) { x0 = *(const f32x4*)(xi + bj * 128); x1 = *(const f32x4*)(xi + bj * 128 + 4); }
                    else { const u32x4 xw = *(const u32x4*)(xb + bj * 128);
                        x0 = (f32x4){__uint_as_float(xw.x << 16), __uint_as_float(xw.x & 0xffff0000u), __uint_as_float(xw.y << 16), __uint_as_float(xw.y & 0xffff0000u)};
                        x1 = (f32x4){__uint_as_float(xw.z << 16), __uint_as_float(xw.z & 0xffff0000u), __uint_as_float(xw.w << 16), __uint_as_float(xw.w & 0xffff0000u)}; }
                    x0 = x0 + gv[bj][0] * acc[ai][bj][m][0]; x1 = x1 + gv[bj][1] * acc[ai][bj][m][1];
                    s += (x0[0] * x0[0] + x0[1] * x0[1]) + (x0[2] * x0[2] + x0[3] * x0[3]) + (x1[0] * x1[0] + x1[1] * x1[1]) + (x1[2] * x1[2] + x1[3] * x1[3]);
                    if (FINAL) { acc[ai][bj][m][0] = x0; acc[ai][bj][m][1] = x1; }
                    else { if (OUTF32) { float* xo = Y + (size_t)row * DM + c0; *(f32x4*)(xo + bj * 128) = x0; *(f32x4*)(xo + bj * 128 + 4) = x1; }
                        else *(u32x4*)(xb + bj * 128) = pack8(x0, x1);
                        if (hasn) *(u32x4*)(XA + blk(row, c0 + bj * 128, 32)) = pack8(x0 * gm[bj][0], x1 * gm[bj][1]); }
                }
                s += __shfl_xor(s, 16); s += __shfl_xor(s, 32);
                if (fq == 0) atomicAdd(ssn + row, s);
            }
        if (FINAL) {
            unsigned* pc = (unsigned*)(w + WS_PCNT) + 64 * pm;
            asm volatile("s_waitcnt vmcnt(0)" ::: "memory");
            __builtin_amdgcn_s_barrier();
            if (threadIdx.x == 0) {
                __hip_atomic_fetch_add(pc, 1u, __ATOMIC_RELEASE, __HIP_MEMORY_SCOPE_AGENT);
                unsigned sp = 0;
                while (__hip_atomic_load(pc, __ATOMIC_ACQUIRE, __HIP_MEMORY_SCOPE_AGENT) < 8u) { __builtin_amdgcn_s_sleep(2); if (++sp > (1u << 22)) break; }
            }
            __builtin_amdgcn_s_barrier(); asm volatile("" ::: "memory");
#pragma unroll
            for (int ai = 0; ai < 2; ++ai)
#pragma unroll
                for (int m = 0; m < 4; ++m) { const int row = pm * 256 + ai * 128 + wr * 64 + m * 16 + fr;
                    const float rs = rsqrtf(__hip_atomic_load(ssn + row, __ATOMIC_RELAXED, __HIP_MEMORY_SCOPE_AGENT) * (1.f / DM) + EPS);
                    float* xo = Y + (size_t)row * DM + c0;
#pragma unroll
                    for (int bj = 0; bj < 2; ++bj) { *(f32x4*)(xo + bj * 128) = acc[ai][bj][m][0] * rs * gm[bj][0]; *(f32x4*)(xo + bj * 128 + 4) = acc[ai][bj][m][1] * rs * gm[bj][1]; } }
        }
    }
};

struct EpiGU {
    unsigned char* ws_; int l;
    __device__ __forceinline__ void operator()(f32x4 (&acc)[2][2][4][2], const Unit& u, int wr, int wc, int fr, int fq, LAS unsigned char* ldsx, int lane) const {
        unsigned char* w = opaque(ws_);
        const float* ss = (const float*)(w + WS_SS) + (size_t)(2 * l + 1) * T;
        const float* bias = (const float*)(w + WS_BIASGU) + (size_t)l * 5 * NGU;
        const int pm = u.pm, pn = u.pn; const bool lat = pm >= 32; const int cond = lat ? 1 + ((pm - 32) >> 4) : 0;
        const int cl = wc * 32 + 8 * fq, ch0 = pn * 128 + cl;
        {
            f32x4 bv[2][2];
#pragma unroll
            for (int bj = 0; bj < 2; ++bj)
#pragma unroll
                for (int n = 0; n < 2; ++n) bv[bj][n] = *(const f32x4*)(bias + cond * NGU + pn * 256 + bj * 128 + cl + 4 * n);
#pragma unroll
            for (int ai = 0; ai < 2; ++ai)
#pragma unroll
                for (int m = 0; m < 4; ++m) { const int row = pm * 256 + ai * 128 + wr * 64 + m * 16 + fr; const float rs = rsqrtf(ss[row] * (1.f / DM) + EPS);
#pragma unroll
                    for (int bj = 0; bj < 2; ++bj)
#pragma unroll
                        for (int n = 0; n < 2; ++n) acc[ai][bj][m][n] = acc[ai][bj][m][n] * rs + bv[bj][n]; }
        }
        LAS float* E = (LAS float*)ldsx;
#pragma unroll
        for (int ai = 0; ai < 2; ++ai) { const int q = 2 * ai + wr;
            if (fr == 0) { *(LAS f32x4*)(E + (q * 2 + 0) * 128 + cl) = acc[ai][0][0][0]; *(LAS f32x4*)(E + (q * 2 + 0) * 128 + cl + 4) = acc[ai][0][0][1]; }
            if (fr == 15) { *(LAS f32x4*)(E + (q * 2 + 1) * 128 + cl) = acc[ai][0][3][0]; *(LAS f32x4*)(E + (q * 2 + 1) * 128 + cl + 4) = acc[ai][0][3][1]; } }
        LDS_WAIT(); __builtin_amdgcn_s_barrier(); asm volatile("" ::: "memory");
        const float* cw = (const float*)(w + WS_SMALL) + SP_CW + (size_t)l * 3 * DFF; const float* cb = (const float*)(w + WS_SMALL) + SP_CB + (size_t)l * DFF;
        bf16_t* HFF = (bf16_t*)(w + WS_HFF); float* EDGE = (float*)(w + WS_EDGE);
        const int srcR = (lane & 48) | ((fr + 15) & 15), srcL = (lane & 48) | ((fr + 1) & 15);
        const int pml = pm - 32;
#pragma unroll
        for (int n = 0; n < 2; ++n) {
            const int ch = ch0 + 4 * n;
            const f32x4 w0 = *(const f32x4*)(cw + ch), w1 = *(const f32x4*)(cw + DFF + ch), w2 = *(const f32x4*)(cw + 2 * DFF + ch), bb = *(const f32x4*)(cb + ch);
#pragma unroll
            for (int ai = 0; ai < 2; ++ai) { const int q = 2 * ai + wr;
                const f32x4 xprev = q > 0 ? *(const LAS f32x4*)(E + ((q - 1) * 2 + 1) * 128 + cl + 4 * n) : (f32x4){0.f, 0.f, 0.f, 0.f};
                const f32x4 xnext = q < 3 ? *(const LAS f32x4*)(E + ((q + 1) * 2 + 0) * 128 + cl + 4 * n) : (f32x4){0.f, 0.f, 0.f, 0.f};
                f32x4 rRp = xprev, rLc;
#pragma unroll
                for (int i = 0; i < 4; ++i) rLc[i] = __shfl(acc[ai][0][0][n][i], srcL);
#pragma unroll
                for (int m = 0; m < 4; ++m) { const int rt = ai * 128 + wr * 64 + m * 16 + fr; const int row = pm * 256 + rt;
                    f32x4 rR, rLn;
#pragma unroll
                    for (int i = 0; i < 4; ++i) { rR[i] = __shfl(acc[ai][0][m][n][i], srcR);
                        if (m < 3) rLn[i] = __shfl(acc[ai][0][m + 1][n][i], srcL); else rLn[i] = xnext[i]; }
                    const f32x4 prev = (fr == 0) ? rRp : rR;
                    const f32x4 next = (fr == 15) ? rLn : rLc;
                    const f32x4 cv = prev * w0 + acc[ai][0][m][n] * w1 + next * w2 + bb;
                    f32x4 hv;
#pragma unroll
                    for (int i = 0; i < 4; ++i) hv[i] = silu_f(cv[i]) * acc[ai][1][m][n][i];
                    bool skip = false;
                    if (lat && (rt == 0 || rt == 255)) {
                        const int side = rt == 0 ? 0 : 1;
                        float* e = EDGE + ((size_t)(pml * 2 + side) * 3) * DFF + ch;
                        *(f32x4*)e = cv; *(f32x4*)(e + DFF) = acc[ai][0][m][n]; *(f32x4*)(e + 2 * DFF) = acc[ai][1][m][n];
                        skip = side == 0 ? ((pml & 15) != 0) : ((pml & 15) != 15);
                    }
                    if (!skip) { u32x2 o; o.x = cvt_pk_bf16(hv[0], hv[1]); o.y = cvt_pk_bf16(hv[2], hv[3]); *(u32x2*)(HFF + blk(row, ch, 88)) = o; }
                    rRp = rR; rLc = rLn;
                }
            }
        }
    }
};

namespace att {
constexpr int KVBLK = 64;
constexpr size_t SHM_V = KVBLK * 128 * 2, SHM_K = KVBLK * 128 * 2;
constexpr float THR = 8.f;
#define KSWZ(row, colB) ((row) * 256 + ((colB) ^ (((row) & 7) << 4)))
#define SBAR() __builtin_amdgcn_sched_barrier(0)
__device__ __forceinline__ int crow(int r, int hi) { return (r & 3) + 8 * (r >> 2) + 4 * hi; }
__device__ __forceinline__ void partialSM(f32x16& p0, f32x16& p1, float& m_reg, float& alpha, const float thr, const bool first) {
#define MX3(a, b, c) __builtin_fmaxf(__builtin_fmaxf((a), (b)), (c))
    float ma = MX3(p0[0], p0[1], p1[0]), mb = MX3(p0[2], p0[3], p1[1]); ma = MX3(ma, p1[2], p1[3]);
#pragma unroll
    for (int r = 4; r < 16; r += 4) { ma = MX3(ma, p0[r], p0[r + 1]); mb = MX3(mb, p0[r + 2], p0[r + 3]); ma = MX3(ma, p1[r], p1[r + 1]); mb = MX3(mb, p1[r + 2], p1[r + 3]); }
#undef MX3
    float pmax = __builtin_fmaxf(ma, mb);
    { auto rr = __builtin_amdgcn_permlane32_swap(__float_as_uint(pmax), __float_as_uint(pmax), false, false);
      pmax = fmaxf(__uint_as_float(rr[0]), __uint_as_float(rr[1])); }
    if (!first && __builtin_expect(__all(pmax <= thr), 1)) { alpha = 1.f; }
    else { const float d = first ? pmax : fmaxf(pmax, 0.f); alpha = first ? 1.f : __builtin_amdgcn_exp2f(-d); m_reg += d;
#pragma unroll
        for (int r = 0; r < 16; ++r) { p0[r] -= d; p1[r] -= d; } }
#pragma unroll
    for (int r = 0; r < 16; ++r) p0[r] = __builtin_amdgcn_exp2f(p0[r]);
}
__device__ __forceinline__ void finishSM(f32x16& p0, f32x16& p1, float alpha, float& l_reg, bf16x8& pa0, bf16x8& pa1, bf16x8& pa2, bf16x8& pa3) {
#pragma unroll
    for (int r = 0; r < 16; ++r) p1[r] = __builtin_amdgcn_exp2f(p1[r]);
    float ps = 0;
#pragma unroll
    for (int r = 0; r < 16; ++r) ps += p0[r];
#pragma unroll
    for (int r = 0; r < 16; ++r) ps += p1[r];
    { auto rr = __builtin_amdgcn_permlane32_swap(__float_as_uint(ps), __float_as_uint(ps), false, false);
      ps = __uint_as_float(rr[0]) + __uint_as_float(rr[1]); }
    l_reg = l_reg * alpha + ps;
#define PK4(P, BASE, OUT) do { unsigned a0 = cvt_pk_bf16(P[BASE + 0], P[BASE + 1]), a1 = cvt_pk_bf16(P[BASE + 2], P[BASE + 3]);   \
    unsigned b0 = cvt_pk_bf16(P[BASE + 4], P[BASE + 5]), b1 = cvt_pk_bf16(P[BASE + 6], P[BASE + 7]);                              \
    auto r0 = __builtin_amdgcn_permlane32_swap(a0, b0, false, false); auto r1 = __builtin_amdgcn_permlane32_swap(a1, b1, false, false); \
    u32x4 w = {r0[0], r1[0], r0[1], r1[1]}; OUT = *reinterpret_cast<bf16x8*>(&w); } while (0)
    PK4(p0, 0, pa0); PK4(p0, 8, pa1); PK4(p1, 0, pa2); PK4(p1, 8, pa3);
#undef PK4
}
template <int DH>
__device__ __forceinline__ void qkt(f32x16& p0, f32x16& p1, const char* Ks, const bf16x8* qr, int r32, int hi, int koff, float negm) {
    f32x16 z;
#pragma unroll
    for (int r = 0; r < 16; ++r) z[r] = negm;
#pragma unroll
    for (int d0 = 0; d0 < DH; ++d0) { const int cb = (d0 * 16 + hi * 8) * 2 + koff;
        const bf16x8 b0 = *reinterpret_cast<const bf16x8*>(Ks + KSWZ(r32, cb));
        const bf16x8 b1 = *reinterpret_cast<const bf16x8*>(Ks + KSWZ(32 + r32, cb));
        if (d0 == 0) { p0 = __builtin_amdgcn_mfma_f32_32x32x16_bf16(b0, qr[0], z, 0, 0, 0); p1 = __builtin_amdgcn_mfma_f32_32x32x16_bf16(b1, qr[0], z, 0, 0, 0); }
        else { p0 = __builtin_amdgcn_mfma_f32_32x32x16_bf16(b0, qr[d0], p0, 0, 0, 0); p1 = __builtin_amdgcn_mfma_f32_32x32x16_bf16(b1, qr[d0], p1, 0, 0, 0); } }
}
__device__ __forceinline__ int v_st(int k, int c) { const int kk = (k & ~0xC) | ((k & 4) << 1) | ((k & 8) >> 1); return ((kk >> 3) * 4 + (c >> 5)) * 512 + ((kk & 7) * 32 + (c & 31)) * 2; }
__device__ __forceinline__ int v_rd_base(int lane) { return ((lane & 3) << 3) | (((lane >> 2) & 3) << 6) | (((lane >> 4) & 1) << 5) | (((lane >> 5) & 1) << 8); }
constexpr int v_rd_off(int d0, int ks, int half) { return d0 * 512 + ks * 4096 + half * 2048; }
template <int OFF> __device__ __forceinline__ s16x4 tr_read(int vb) {
    s16x4 r; asm volatile("ds_read_b64_tr_b16 %0, %1 offset:%2" : "=&v"(r) : "v"(vb), "i"(OFF) : "memory"); return r;
}
template <int D0> __device__ __forceinline__ void pv_one(f32x16& od, int vb, bf16x8 pa0, bf16x8 pa1, bf16x8 pa2, bf16x8 pa3) {
    const s16x4 l0 = tr_read<v_rd_off(D0, 0, 0)>(vb), h0 = tr_read<v_rd_off(D0, 0, 1)>(vb), l1 = tr_read<v_rd_off(D0, 1, 0)>(vb), h1 = tr_read<v_rd_off(D0, 1, 1)>(vb);
    const s16x4 l2 = tr_read<v_rd_off(D0, 2, 0)>(vb), h2 = tr_read<v_rd_off(D0, 2, 1)>(vb), l3 = tr_read<v_rd_off(D0, 3, 0)>(vb), h3 = tr_read<v_rd_off(D0, 3, 1)>(vb);
    asm volatile("s_waitcnt lgkmcnt(0)" ::: "memory"); SBAR();
#define PK(L, H) (bf16x8){L[0], L[1], L[2], L[3], H[0], H[1], H[2], H[3]}
    od = __builtin_amdgcn_mfma_f32_32x32x16_bf16(pa0, PK(l0, h0), od, 0, 0, 0);
    od = __builtin_amdgcn_mfma_f32_32x32x16_bf16(pa1, PK(l1, h1), od, 0, 0, 0);
    od = __builtin_amdgcn_mfma_f32_32x32x16_bf16(pa2, PK(l2, h2), od, 0, 0, 0);
    od = __builtin_amdgcn_mfma_f32_32x32x16_bf16(pa3, PK(l3, h3), od, 0, 0, 0);
#undef PK
}
__device__ __forceinline__ void pv_d0(f32x16* o, int vb, bf16x8 pa0, bf16x8 pa1, bf16x8 pa2, bf16x8 pa3) {
    pv_one<0>(o[0], vb, pa0, pa1, pa2, pa3); pv_one<1>(o[1], vb, pa0, pa1, pa2, pa3); pv_one<2>(o[2], vb, pa0, pa1, pa2, pa3); pv_one<3>(o[3], vb, pa0, pa1, pa2, pa3);
}
template <int DH, int LDK>
__device__ __forceinline__ void body(const bf16_t* __restrict__ Qw, const bf16_t* __restrict__ Kh, const bf16_t* __restrict__ Vh, int seq, int koff, float C, char* lds, f32x16 (&o)[4]) {
    int tid = threadIdx.x; asm volatile("" : "+v"(tid));
    const int wid = tid >> 6, lane = tid & 63, r32 = lane & 31, hi = lane >> 5;
    char* V_lds = lds; char* K_lds = lds + 2 * SHM_V;
    float* ws = (float*)(lds + 2 * SHM_V + 2 * SHM_K) + wid * 64; float* li_l = ws; float* al_l = ws + 32;
    float m_reg = 0.f, l_reg = 0; bf16x8 qr[DH];
    const float thr = THR * 1.4426950408889634f;
#pragma unroll
    for (int d = 0; d < 4; ++d) o[d] = f32x16{};
#pragma unroll
    for (int d0 = 0; d0 < DH; ++d0) qr[d0] = *reinterpret_cast<const bf16x8*>(Qw + d0 * 16);
    const int sr = tid >> 4, sc = (tid & 15) * 8, vst0 = v_st(sr, sc), vst1 = v_st(32 + sr, sc);
    const int vb0 = (int)(uintptr_t)V_lds + v_rd_base(lane);
    struct { bf16x8 vs0, vs1, ks0, ks1; } sr_[2];
#define SLOAD(i, k0) do { sr_[i].vs0 = *(const bf16x8*)(&Vh[(long)((k0) + sr) * LDK + sc]); sr_[i].vs1 = *(const bf16x8*)(&Vh[(long)((k0) + 32 + sr) * LDK + sc]); \
    sr_[i].ks0 = *(const bf16x8*)(&Kh[(long)((k0) + sr) * LDK + sc]); sr_[i].ks1 = *(const bf16x8*)(&Kh[(long)((k0) + 32 + sr) * LDK + sc]); } while (0)
#define SWRITE(b, i) do { *(bf16x8*)(V_lds + (b) * SHM_V + vst0) = sr_[i].vs0;          \
    *(bf16x8*)(V_lds + (b) * SHM_V + vst1) = sr_[i].vs1; const int kc = sc * 2;               \
    *(bf16x8*)(K_lds + (b) * SHM_K + KSWZ(sr, kc)) = sr_[i].ks0;                       \
    *(bf16x8*)(K_lds + (b) * SHM_K + KSWZ(32 + sr, kc)) = sr_[i].ks1; } while (0)
#define SWAIT() asm volatile("s_waitcnt vmcnt(4)" ::: "memory")
#define RESC(a) do { if (__any((a) < 1.f)) { if (hi == 0) al_l[r32] = (a); asm volatile("s_waitcnt lgkmcnt(0)" ::: "memory"); \
    _Pragma("unroll") for (int d = 0; d < 4; ++d) _Pragma("unroll") for (int r = 0; r < 16; ++r) o[d][r] *= al_l[crow(r, hi)]; } } while (0)
    f32x16 pA0, pA1, pB0, pB1; float alA, alB; bf16x8 pa0, pa1, pa2, pa3; const int NT = seq / KVBLK;
    constexpr int SE = 0, SO = 1;
    SLOAD(SE, 0); asm volatile("s_waitcnt vmcnt(0)" ::: "memory"); SWRITE(0, SE); __syncthreads();
    qkt<DH>(pA0, pA1, K_lds, qr, r32, hi, koff, 0.f); partialSM(pA0, pA1, m_reg, alA, thr, true);
    SLOAD(SO, KVBLK); if (2 < NT) SLOAD(SE, 2 * KVBLK);
    SWAIT(); SWRITE(1, SO); __syncthreads();
    for (int j = 1; j + 1 < NT; j += 2) {
        SBAR(); qkt<DH>(pB0, pB1, K_lds + SHM_K, qr, r32, hi, koff, -m_reg);
        finishSM(pA0, pA1, alA, l_reg, pa0, pa1, pa2, pa3); SBAR();
        SLOAD(SO, (j + 2) * KVBLK); SBAR();
        pv_d0(o, vb0, pa0, pa1, pa2, pa3); partialSM(pB0, pB1, m_reg, alB, thr, false);
        __syncthreads(); SWAIT(); SWRITE(0, SE);
        RESC(alB); __syncthreads();
        SBAR(); qkt<DH>(pA0, pA1, K_lds, qr, r32, hi, koff, -m_reg);
        finishSM(pB0, pB1, alB, l_reg, pa0, pa1, pa2, pa3); SBAR();
        if (j + 3 < NT) SLOAD(SE, (j + 3) * KVBLK); SBAR();
        pv_d0(o, vb0 + (int)SHM_V, pa0, pa1, pa2, pa3); partialSM(pA0, pA1, m_reg, alA, thr, false);
        __syncthreads(); SWAIT(); SWRITE(1, SO);
        RESC(alA); __syncthreads();
    }
    SBAR(); qkt<DH>(pB0, pB1, K_lds + SHM_K, qr, r32, hi, koff, -m_reg);
    finishSM(pA0, pA1, alA, l_reg, pa0, pa1, pa2, pa3); SBAR();
    pv_d0(o, vb0, pa0, pa1, pa2, pa3); partialSM(pB0, pB1, m_reg, alB, thr, false);
    __syncthreads(); RESC(alB);
    finishSM(pB0, pB1, alB, l_reg, pa0, pa1, pa2, pa3); SBAR();
    pv_d0(o, vb0 + (int)SHM_V, pa0, pa1, pa2, pa3);
    if (hi == 0) li_l[r32] = l_reg; asm volatile("s_waitcnt lgkmcnt(0)" ::: "memory");
#pragma unroll
    for (int r = 0; r < 16; ++r) { const float rl = __builtin_amdgcn_rcpf(li_l[crow(r, hi)]);
#pragma unroll
        for (int d = 0; d < 4; ++d) o[d][r] *= rl; }
#undef SLOAD
#undef SWRITE
#undef SWAIT
#undef RESC
}
}

__device__ __forceinline__ void transpose_item(const float* W, int K, int N, bf16_t* WT, int row0, int k0, int srccol4, LAS float* scr, int lane) {
    const int r = lane >> 3, c4 = lane & 7;
    f32x4 v[8];
#pragma unroll
    for (int i = 0; i < 8; ++i) v[i] = *(const f32x4*)(W + (size_t)(k0 + 8 * i + r) * N + srccol4);
#pragma unroll
    for (int i = 0; i < 8; ++i) { LAS float* d = scr + (8 * i + r) * 33 + 4 * c4; d[0] = v[i][0]; d[1] = v[i][1]; d[2] = v[i][2]; d[3] = v[i][3]; }
    LDS_WAIT(); asm volatile("" ::: "memory");
    const int c = lane & 7;
#pragma unroll
    for (int j = 0; j < 4; ++j) { const int n = (lane >> 3) + 8 * j; const LAS float* sp = scr + (8 * c) * 33 + n;
        u32x4 o; o.x = cvt_pk_bf16(sp[0 * 33], sp[1 * 33]); o.y = cvt_pk_bf16(sp[2 * 33], sp[3 * 33]); o.z = cvt_pk_bf16(sp[4 * 33], sp[5 * 33]); o.w = cvt_pk_bf16(sp[6 * 33], sp[7 * 33]);
        *(u32x4*)(WT + blk(row0 + n, k0 + 8 * c, K >> 6)) = o; }
    LDS_WAIT(); asm volatile("" ::: "memory");
}

#define XB_TMO      128
#define XB_XCNT(j)  (256  + 64 * (j))
#define XB_XSUB(j)  (1280 + 64 * (j))
#define XB_XGEN(j)  (2304 + 64 * (j))
#define XB_TOP      3328
#define XB_TOPGEN   3392
#define XCD_BAR_WORDS 3456
#define XB_SPIN_CAP (1u << 18)
__device__ __forceinline__ unsigned xb_ld(unsigned* p)              { return __hip_atomic_load(p, __ATOMIC_RELAXED, __HIP_MEMORY_SCOPE_AGENT); }
__device__ __forceinline__ unsigned xb_add(unsigned* p, unsigned v) { return __hip_atomic_fetch_add(p, v, __ATOMIC_RELAXED, __HIP_MEMORY_SCOPE_AGENT); }
__device__ __forceinline__ unsigned xb_xcc_id() { return (unsigned)__builtin_amdgcn_s_getreg((3 << 11) | 20) & 0xFu; }
#define XB_SPIN(cond, bar) do { unsigned _sp = 0; while (cond) { __builtin_amdgcn_s_sleep(1); \
    if ((++_sp & 255u) == 0u) { if (xb_ld(&(bar)[XB_TMO])) break; if (_sp > XB_SPIN_CAP) { atomicAdd(&(bar)[XB_TMO], 1u); break; } } } } while (0)
struct XcdBarrier { unsigned* bar; unsigned x; volatile LAS unsigned* st; };
__device__ __forceinline__ XcdBarrier xcd_barrier_post(unsigned* bar, volatile LAS unsigned* st) {
    XcdBarrier b; b.bar = bar; b.x = xb_xcc_id(); b.st = st;
    if (threadIdx.x == 0) (void)xb_add(&bar[XB_XCNT(b.x)], 1u);
    return b;
}
__device__ __forceinline__ void xcd_barrier_complete(unsigned* bar, unsigned x, unsigned& nloc, unsigned& nx) {
    const unsigned G = gridDim.x * gridDim.y * gridDim.z;
    unsigned sum, cnt, mine, sp = 0u;
    for (;;) {
        sum = 0u; cnt = 0u; mine = 0u;
#pragma unroll
        for (unsigned j = 0; j < 16; ++j) { const unsigned c = xb_ld(&bar[XB_XCNT(j)]); sum += c; cnt += (c > 0u) ? 1u : 0u; mine = (j == x) ? c : mine; }
        if (sum == G) break;
        __builtin_amdgcn_s_sleep(1);
        if ((++sp & 255u) == 0u) { if (xb_ld(&bar[XB_TMO])) break; if (sp > XB_SPIN_CAP) { atomicAdd(&bar[XB_TMO], 1u); break; } }
    }
    nloc = mine > 0u ? mine : 1u; nx = cnt > 0u ? cnt : 1u;
}
__device__ __forceinline__ void xcd_barrier(const XcdBarrier& b) {
    asm volatile("s_waitcnt vmcnt(0)" ::: "memory");
    __syncthreads();
    if (threadIdx.x == 0) {
        unsigned* bar = b.bar;
        __builtin_amdgcn_s_waitcnt(0);
        unsigned nloc = b.st[0], nx = b.st[1];
        if (nloc == 0u) { xcd_barrier_complete(bar, b.x, nloc, nx); b.st[0] = nloc; b.st[1] = nx; }
        const unsigned old = xb_add(&bar[XB_XSUB(b.x)], 1u);
        const unsigned gen = old / nloc;
        if (old + 1u == (gen + 1u) * nloc) {
            __builtin_amdgcn_fence(__ATOMIC_RELEASE, "agent");
            asm volatile("s_waitcnt vmcnt(0)" ::: "memory");
            const unsigned og = xb_add(&bar[XB_TOP], 1u);
            const unsigned tg = og / nx;
            if (og + 1u == (tg + 1u) * nx) xb_add(&bar[XB_TOPGEN], 1u);
            else XB_SPIN(xb_ld(&bar[XB_TOPGEN]) == tg, bar);
            __builtin_amdgcn_fence(__ATOMIC_ACQUIRE, "agent");
            xb_add(&bar[XB_XGEN(b.x)], 1u);
            asm volatile("s_waitcnt vmcnt(0)" ::: "memory");
        } else {
            XB_SPIN(xb_ld(&bar[XB_XGEN(b.x)]) == gen, bar);
            __builtin_amdgcn_fence(__ATOMIC_ACQUIRE, "agent");
            asm volatile("s_waitcnt vmcnt(0)" ::: "memory");
        }
    }
    __syncthreads();
}

__global__ void __launch_bounds__(512, 2) fwd_megakernel(Params p) {
    extern __shared__ __attribute__((aligned(16))) unsigned char lds_raw[];
    cg::grid_group grid = cg::this_grid();
    LAS unsigned char* lds = (LAS unsigned char*)lds_raw;
    const int G = gridDim.x, bid = blockIdx.x;
    const int NGW = G * 8; const long NGT = (long)G * 512;
    unsigned char* const ws0 = p.ws; float* const out0 = p.out;
    { volatile LAS unsigned* st0 = (volatile LAS unsigned*)(lds + LDSX_OFF + 12288 + 64); if (threadIdx.x < 2) st0[threadIdx.x] = 0u; }
    __syncthreads();
    {
        constexpr long NZ = (long)(WS_BAR + 16384) / 16;
        for (long i = (long)blockIdx.x * 512 + threadIdx.x; i < NZ; i += (long)gridDim.x * 512) *(u32x4*)(ws0 + WS_CTL + i * 16) = (u32x4){0u, 0u, 0u, 0u};
    }
#define GSYNC() do { XcdBarrier xb_; xb_.bar = (unsigned*)(opaque(ws0) + WS_BAR); xb_.x = xb_xcc_id(); xb_.st = (volatile LAS unsigned*)(lds + LDSX_OFF + 12288 + 64); xcd_barrier(xb_); } while (0)
#define TIDS() int tid = threadIdx.x; asm volatile("" : "+v"(tid)); const int lane = tid & 63, wave = __builtin_amdgcn_readfirstlane(tid >> 6); const int gw = bid * 8 + wave; const long gtid = (long)bid * 512 + tid; (void)lane; (void)gw; (void)gtid;

    if (bid < 192) { TIDS();
        const float* cvec = p.in[6]; const float* c_ctx = p.in[7]; const float* w_ada = p.in[10]; const float* b_ada = p.in[11];
        float* MOD = (float*)(ws0 + WS_MOD);
        LAS float* sl = (LAS float*)lds;
        LAS float* red = (LAS float*)(lds + 40960);
        for (int i = tid; i < 5 * DM; i += 512) { const int cnd = i / DM, k = i % DM; const float v = cnd == 0 ? c_ctx[k] : cvec[(cnd - 1) * DM + k]; sl[i] = silu_f(v); }
        __syncthreads();
        const int l = bid / 96, cgp = bid % 96, tx = tid & 31, ky = tid >> 5;
        const float* Wp = w_ada + (size_t)l * DM * 12288 + (size_t)(ky * 128) * 12288 + cgp * 128 + 4 * tx;
        f32x4 a[5];
#pragma unroll
        for (int c = 0; c < 5; ++c) a[c] = (f32x4){0.f, 0.f, 0.f, 0.f};
#pragma unroll 8
        for (int k = 0; k < 128; ++k) { const f32x4 wv = *(const f32x4*)(Wp + (size_t)k * 12288);
#pragma unroll
            for (int c = 0; c < 5; ++c) a[c] += wv * sl[c * DM + ky * 128 + k]; }
#pragma unroll
        for (int c = 0; c < 5; ++c) *(LAS f32x4*)(red + (ky * 5 + c) * 128 + 4 * tx) = a[c];
        __syncthreads();
        for (int i = tid; i < 640; i += 512) { const int c = i >> 7, col = i & 127; float sm = 0.f;
#pragma unroll
            for (int k = 0; k < 16; ++k) sm += red[(k * 5 + c) * 128 + col];
            MOD[(size_t)(l * 5 + c) * 12288 + cgp * 128 + col] = sm + b_ada[l * 12288 + cgp * 128 + col]; }
        __syncthreads();
    }
    {
        TIDS();
        const float* w_in = p.in[12]; const float* w_out = p.in[20]; const float* w_gate = p.in[21]; const float* w_up = p.in[22]; const float* w_down = p.in[25];
        bf16_t* WIN = (bf16_t*)(ws0 + WS_WIN); bf16_t* WOUT = (bf16_t*)(ws0 + WS_WOUT); bf16_t* WGU = (bf16_t*)(ws0 + WS_WGU); bf16_t* WDN = (bf16_t*)(ws0 + WS_WDN);
        LAS float* scr = (LAS float*)(lds + wave * 16384);
        constexpr int I_IN = 32 * 96, I_OUT = 32 * 64, I_GU = 32 * 352, I_DN = 88 * 64, I_L = I_IN + I_OUT + I_GU + I_DN;
        for (int it = gw; it < 2 * I_L; it += NGW) {
            const int l = it / I_L; int r = it % I_L;
            if (r < I_IN) { const int kb = r / 96, nb = r % 96; const int L = nb * 32 + 4 * (lane & 7);
                transpose_item(w_in + (size_t)l * DM * DIN, DM, DIN, WIN + (size_t)l * NIN * DM, nb * 32, kb * 64, win_srccol(L), scr, lane); continue; }
            r -= I_IN;
            if (r < I_OUT) { const int kb = r / 64, nb = r % 64;
                transpose_item(w_out + (size_t)l * DM * DM, DM, DM, WOUT + (size_t)l * DM * DM, nb * 32, kb * 64, nb * 32 + 4 * (lane & 7), scr, lane); continue; }
            r -= I_OUT;
            if (r < I_GU) { const int kb = r / 352, nb = r % 352; const int L0 = nb * 32, pn = L0 >> 8, bj = (L0 >> 7) & 1, lam0 = L0 & 127;
                transpose_item((bj ? w_up : w_gate) + (size_t)l * DM * DFF, DM, DFF, WGU + (size_t)l * NGU * DM, L0, kb * 64, pn * 128 + lam0 + 4 * (lane & 7), scr, lane); continue; }
            r -= I_GU;
            { const int kb = r / 64, nb = r % 64;
                transpose_item(w_down + (size_t)l * DFF * DM, DFF, DM, WDN + (size_t)l * DM * DFF, nb * 32, kb * 64, nb * 32 + 4 * (lane & 7), scr, lane); }
        }
        LAS float* trg = scr + 16 * 128;
        for (int j = lane; j < 128; j += 64) { trg[j] = __builtin_amdgcn_cosf((float)j * (1.f / 128.f)); trg[128 + j] = __builtin_amdgcn_sinf((float)j * (1.f / 128.f)); }
        LDS_WAIT();
        for (int it = gw; it < 2 * 2 * 4 * 128 * 4; it += NGW) {
            const int mb = it & 3, kb = (it >> 2) & 127, g = (it >> 9) & 3, cs = (it >> 11) & 1, l = it >> 12;
            const float* Wl = w_in + (size_t)l * DM * DIN + 3072 + g * 128;
#pragma unroll
            for (int i = 0; i < 8; ++i) { const int kk = 2 * i + (lane >> 5);
                *(LAS f32x4*)(scr + kk * 128 + 4 * (lane & 31)) = *(const f32x4*)(Wl + (size_t)(kb * 16 + kk) * DIN + 4 * (lane & 31)); }
            LDS_WAIT(); asm volatile("" ::: "memory");
            const int m = mb * 32 + (lane & 31), kh = lane >> 5;
            float a8[8];
#pragma unroll
            for (int i = 0; i < 8; ++i) a8[i] = 0.f;
            const LAS float* tt = trg + cs * 128;
            for (int c = 0; c < 128; ++c) { const float tv = tt[(c * m) & 127];
#pragma unroll
                for (int i = 0; i < 8; ++i) a8[i] += scr[(kh * 8 + i) * 128 + c] * tv; }
            u32x4 o; o.x = cvt_pk_bf16(a8[0], a8[1]); o.y = cvt_pk_bf16(a8[2], a8[3]); o.z = cvt_pk_bf16(a8[4], a8[5]); o.w = cvt_pk_bf16(a8[6], a8[7]);
            *(u32x4*)(WIN + (size_t)l * NIN * DM + blk(3072 + cs * 512 + g * 128 + m, kb * 16 + kh * 8, 32)) = o;
            LDS_WAIT(); asm volatile("" ::: "memory");
        }
    }
    {
        TIDS();
        bf16_t* DFTC = (bf16_t*)(ws0 + WS_DFTC); bf16_t* DFTL = (bf16_t*)(ws0 + WS_DFTL); float* ROPE = (float*)(ws0 + WS_ROPE); float* LAM = (float*)(ws0 + WS_LAM);
        const float scl = 1.f / sqrtf(4096.f * 128.f);
        for (long i = gtid; i < 512L * 512 / 8; i += NGT) { const int R = (int)(i >> 6), c8 = (int)(i & 63) * 8, cs = c8 >> 8, n0 = c8 & 255;
            const int im = (R >> 7) & 1, k1 = (R >> 8) * 128 + (R & 127);
            float v[8];
#pragma unroll
            for (int j = 0; j < 8; ++j) { const float ph = (float)((k1 * (n0 + j)) & 255) * (1.f / 256.f);
                const float c = __builtin_amdgcn_cosf(ph), sn = __builtin_amdgcn_sinf(ph);
                v[j] = (im == 0 ? (cs == 0 ? c : -sn) : (cs == 0 ? -sn : -c)) * scl; }
            u32x4 o; o.x = cvt_pk_bf16(v[0], v[1]); o.y = cvt_pk_bf16(v[2], v[3]); o.z = cvt_pk_bf16(v[4], v[5]); o.w = cvt_pk_bf16(v[6], v[7]);
            *(u32x4*)(DFTL + i * 8) = o; }
        const float scc = 1.f / sqrtf(256.f * 128.f);
        for (long i = gtid; i < 256L * 512 / 8; i += NGT) { const int k = (int)(i >> 6), c8 = (int)(i & 63) * 8, cs = c8 >> 8, n0 = c8 & 255;
            float v[8];
#pragma unroll
            for (int j = 0; j < 8; ++j) { const float ph = (float)((k * (n0 + j)) & 255) * (1.f / 256.f); v[j] = (cs ? -__builtin_amdgcn_sinf(ph) : __builtin_amdgcn_cosf(ph)) * scc; }
            u32x4 o; o.x = cvt_pk_bf16(v[0], v[1]); o.y = cvt_pk_bf16(v[2], v[3]); o.z = cvt_pk_bf16(v[4], v[5]); o.w = cvt_pk_bf16(v[6], v[7]);
            *(u32x4*)(DFTC + i * 8) = o; }
        for (long i = gtid; i < 2048 + 1024; i += NGT) {
            if (i < 2048) { const int pos = (int)i >> 5, j = (int)i & 31; const float ang = (float)pos * powf(10000.f, -(float)j / 32.f); ROPE[i] = cosf(ang); ROPE[2048 + i] = sinf(ang); }
            else { const int ii = (int)i - 2048, pos = ii >> 4, j = ii & 15; const float ang = (float)pos * powf(10000.f, -(float)j / 16.f); ROPE[4096 + ii] = cosf(ang); ROPE[5120 + ii] = sinf(ang); }
        }
        if (gtid < 2) { const int l = (int)gtid; float s1 = 0.f, s2 = 0.f;
            const float* lq1 = p.in[15]; const float* lk1 = p.in[16]; const float* lq2 = p.in[17]; const float* lk2 = p.in[18];
            for (int j = 0; j < 64; ++j) { s1 += lq1[l * 64 + j] * lk1[l * 64 + j]; s2 += lq2[l * 64 + j] * lk2[l * 64 + j]; }
            LAM[l] = expf(s1) - expf(s2) + (0.8f - 0.6f * expf(-0.3f * (float)l)); }
        float* SP = (float*)(ws0 + WS_SMALL);
        for (long i = gtid; i < SP_END; i += NGT) { const int j = (int)i; float v;
            if (j < SP_N2) v = p.in[8][j - SP_N1]; else if (j < SP_QN) v = p.in[9][j - SP_N2]; else if (j < SP_KN) v = p.in[13][j - SP_QN];
            else if (j < SP_SUB) v = p.in[14][j - SP_KN]; else if (j < SP_FIN) v = p.in[19][j - SP_SUB]; else if (j < SP_CB) v = p.in[26][j - SP_FIN];
            else if (j < SP_CW) v = p.in[24][j - SP_CB]; else v = p.in[23][j - SP_CW];
            SP[j] = v; }
        bf16_t* CST = (bf16_t*)(ws0 + WS_CST);
        for (int r = gw; r < 2048; r += NGW) {
            const int l = r >> 10, b = (r >> 8) & 3, j = r & 255; const size_t cro = (size_t)((b * 2 + l) * 256 + j);
            bf16_t* dst = CST + (size_t)r * 1536;
            { const int L = lane * 4; const int sc_ = win_srccol(L);
              const f32x4 v = *(const f32x4*)(p.in[2] + cro * 256 + sc_); u32x2 wv; wv.x = cvt_pk_bf16(v[0], v[1]); wv.y = cvt_pk_bf16(v[2], v[3]); *(u32x2*)(dst + L) = wv;
              const f32x4 v2 = *(const f32x4*)(p.in[3] + cro * 256 + L); u32x2 w2; w2.x = cvt_pk_bf16(v2[0], v2[1]); w2.y = cvt_pk_bf16(v2[2], v2[3]); *(u32x2*)(dst + 256 + L) = w2; }
#pragma unroll
            for (int h2 = 0; h2 < 2; ++h2) { const int L = h2 * 256 + lane * 4; const int sc_ = win_srccol(2048 + L) - 2048;
              const f32x4 v = *(const f32x4*)(p.in[4] + cro * 512 + sc_); u32x2 wv; wv.x = cvt_pk_bf16(v[0], v[1]); wv.y = cvt_pk_bf16(v[2], v[3]); *(u32x2*)(dst + 512 + L) = wv;
              const f32x4 v2 = *(const f32x4*)(p.in[5] + cro * 512 + L); u32x2 w2; w2.x = cvt_pk_bf16(v2[0], v2[1]); w2.y = cvt_pk_bf16(v2[2], v2[3]); *(u32x2*)(dst + 1024 + L) = w2; }
        }
    }
    grid.sync();
    (void)xcd_barrier_post((unsigned*)(ws0 + WS_BAR), (volatile LAS unsigned*)(lds + LDSX_OFF + 12288 + 64));
    {
        TIDS();
        const float* x_prompt = p.in[0]; const float* x_sample = p.in[1]; const float* norm1_g = p.in[8];
        const float* MOD = (const float*)(ws0 + WS_MOD); float* SS = (float*)(ws0 + WS_SS); bf16_t* XA = (bf16_t*)(ws0 + WS_XA);
        for (int row = gw; row < T; row += NGW) {
            const int cond = row < NCTX ? 0 : 1 + ((row - NCTX) >> 12);
            const float* xr = row < NCTX ? x_prompt + (size_t)row * DM : x_sample + (size_t)(row - NCTX) * DM;
            const float* sc = MOD + (size_t)(0 * 5 + cond) * 12288 + 1 * DM;
            float sm = 0.f;
#pragma unroll
            for (int j = 0; j < 4; ++j) { const int c = j * 512 + lane * 8;
                const f32x4 x0 = *(const f32x4*)(xr + c), x1 = *(const f32x4*)(xr + c + 4);
                const f32x4 g0 = *(const f32x4*)(norm1_g + c) * (*(const f32x4*)(sc + c) + 1.f), g1 = *(const f32x4*)(norm1_g + c + 4) * (*(const f32x4*)(sc + c + 4) + 1.f);
                sm += (x0[0] * x0[0] + x0[1] * x0[1]) + (x0[2] * x0[2] + x0[3] * x0[3]) + (x1[0] * x1[0] + x1[1] * x1[1]) + (x1[2] * x1[2] + x1[3] * x1[3]);
                *(u32x4*)(XA + blk(row, c, 32)) = pack8(x0 * g0, x1 * g1); }
            sm = wave_sum(sm);
            if (lane == 0) SS[row] = sm;
        }
        const bf16_t* WIN = (const bf16_t*)(ws0 + WS_WIN); const bf16_t* WGU = (const bf16_t*)(ws0 + WS_WGU);
        float* BIASIN = (float*)(ws0 + WS_BIASIN); float* BIASGU = (float*)(ws0 + WS_BIASGU);
        for (int it = gw; it < 2 * (NIN + NGU); it += NGW) {
            const int l = it / (NIN + NGU), r = it % (NIN + NGU); const bool isin = r < NIN; const int L = isin ? r : r - NIN;
            const bf16_t* br = isin ? WIN + (size_t)l * NIN * DM : WGU + (size_t)l * NGU * DM;
            float a[5] = {0.f, 0.f, 0.f, 0.f, 0.f};
#pragma unroll
            for (int j = 0; j < 4; ++j) { const int c = j * 512 + lane * 8; const u32x4 wv = *(const u32x4*)(br + blk(L, c, 32));
                float wf[8]; wf[0] = __uint_as_float(wv.x << 16); wf[1] = __uint_as_float(wv.x & 0xffff0000u); wf[2] = __uint_as_float(wv.y << 16); wf[3] = __uint_as_float(wv.y & 0xffff0000u);
                wf[4] = __uint_as_float(wv.z << 16); wf[5] = __uint_as_float(wv.z & 0xffff0000u); wf[6] = __uint_as_float(wv.w << 16); wf[7] = __uint_as_float(wv.w & 0xffff0000u);
#pragma unroll
                for (int cnd = 0; cnd < 5; ++cnd) { const float* sh = MOD + (size_t)(l * 5 + cnd) * 12288 + (isin ? 0 : 3 * DM) + c;
                    const f32x4 s0 = *(const f32x4*)sh, s1 = *(const f32x4*)(sh + 4);
                    a[cnd] += (wf[0] * s0[0] + wf[1] * s0[1]) + (wf[2] * s0[2] + wf[3] * s0[3]) + (wf[4] * s1[0] + wf[5] * s1[1]) + (wf[6] * s1[2] + wf[7] * s1[3]); } }
#pragma unroll
            for (int cnd = 0; cnd < 5; ++cnd) { const float sm = wave_sum(a[cnd]);
                if (lane == 0) { if (isin) BIASIN[(size_t)(l * 5 + cnd) * NIN + L] = sm; else BIASGU[(size_t)(l * 5 + cnd) * NGU + L] = sm; } }
        }
    }
    GSYNC();

    for (int l = 0; l < 2; ++l) {
        {
            TIDS();
            unsigned char* w = opaque(ws0);
            const bf16_t* CST = (const bf16_t*)(w + WS_CST) + (size_t)l * 1024 * 1536;
            for (int r = gw; r < 1024; r += NGW) {
                const int b = r >> 8, j = r & 255; const size_t kr = (size_t)(NCTX + b * 4352 + j);
#pragma unroll
                for (int t3 = 0; t3 < 3; ++t3) { const int c = t3 * 64 + lane; const u32x4 v = *(const u32x4*)(CST + (size_t)r * 1536 + c * 8);
                    bf16_t* d;
                    if (c < 32) d = (bf16_t*)(w + WS_KA) + kr * 256 + c * 8; else if (c < 64) d = (bf16_t*)(w + WS_VA) + kr * 256 + (c - 32) * 8;
                    else if (c < 128) d = (bf16_t*)(w + WS_KB) + kr * 512 + (c - 64) * 8; else d = (bf16_t*)(w + WS_VB) + kr * 512 + (c - 128) * 8;
                    *(u32x4*)d = v; }
            }
            pg8::Gemm g{(const bf16_t*)(w + WS_XA), (const bf16_t*)(w + WS_WIN) + (size_t)l * NIN * DM, T, NIN, DM}; pg8::StaticOrder S; S.init(T, NIN, G, bid);
            EpiIn E{ws0, out0, l};
            pg8::gemm_phase<EpiIn, pg8::StaticOrder, true, true>(lds, g, S, E);
        }
        GSYNC();
        {
            { unsigned char* w = opaque(ws0);
              pg8::Gemm g{(const bf16_t*)(w + WS_DFTL), (const bf16_t*)(w + WS_FTL), 512, 32768, 512}; pg8::StridedUnits S{bid, G, 256}; EpiFft E{ws0};
              pg8::gemm_phase<EpiFft, pg8::StridedUnits>(lds, g, S, E); }
            { unsigned char* w = opaque(ws0);
              pg8::Gemm g{(const bf16_t*)(w + WS_DFTC), (const bf16_t*)(w + WS_FTC), 256, 16384, 512}; pg8::OneUnit S{bid < 64 ? 1 : 0, 0, bid}; EpiDft E{ws0, 0};
              pg8::gemm_phase<EpiDft, pg8::OneUnit>(lds, g, S, E); }
            __syncthreads();
            LAS unsigned* slot = (LAS unsigned*)(lds + LDSX_OFF + 12288);
            char* attl = (char*)lds_raw;
            for (;;) {
                TIDS();
                const int r32 = lane & 31, hi = lane >> 5;
                unsigned char* w = opaque(ws0);
                if (tid == 0) *slot = atomicAdd((unsigned*)(w + WS_CNT) + 64 * l, 1u);
                __syncthreads();
                const int q = (int)*slot;
                __syncthreads();
                if (q >= 1536) break;
                bf16_t* MIX = (bf16_t*)(w + WS_MIX);
                f32x16 o[4];
                if (q < 512 || (q >= 1024 && q < 1280)) {
                    int tok0, kr0, h, seq;
                    if (q < 512) { const int b = q >> 7; h = (q >> 4) & 7; const int qb = q & 15; tok0 = NCTX + b * 4096 + qb * 256; kr0 = NCTX + b * 4352; seq = 4352; }
                    else { const int qq = q - 1024, b = qq >> 3; h = qq & 7; tok0 = b * 256; kr0 = b * 256; seq = 256; }
                    const bf16_t* Qw = (const bf16_t*)(w + WS_QA) + (size_t)(tok0 + wave * 32 + r32) * 1024 + h * 128 + hi * 8;
                    att::body<8, 256>(Qw, (const bf16_t*)(w + WS_KA) + (size_t)kr0 * 256 + (h >> 2) * 128, (const bf16_t*)(w + WS_VA) + (size_t)kr0 * 256 + (h >> 2) * 128, seq, 0,
                                      0.08838834764831845f * 1.4426950408889634f, attl, o);
#pragma unroll
                    for (int r = 0; r < 16; ++r) { const int orow = tok0 + wave * 32 + att::crow(r, hi);
#pragma unroll
                        for (int d0 = 0; d0 < 4; ++d0) MIX[(size_t)orow * DM + h * 128 + d0 * 32 + r32] = (bf16_t)(cvt_pk_bf16(o[d0][r], 0.f) & 0xffff); }
                } else {
                    int tok0, kr0, hb, seq;
                    if (q < 1024) { const int qq = q - 512, b = qq >> 7; hb = (qq >> 5) & 3; const int qb = qq & 31; tok0 = NCTX + b * 4096 + qb * 128; kr0 = NCTX + b * 4352; seq = 4352; }
                    else { const int qq = q - 1280, b = qq >> 3; hb = (qq >> 1) & 3; const int qb = qq & 1; tok0 = b * 256 + qb * 128; kr0 = b * 256; seq = 256; }
                    const int br = wave >> 2, ws4 = wave & 3;
                    const bf16_t* Qw = (const bf16_t*)(w + WS_QB) + (size_t)(tok0 + ws4 * 32 + r32) * 512 + hb * 128 + br * 64 + hi * 8;
                    att::body<4, 512>(Qw, (const bf16_t*)(w + WS_KB) + (size_t)kr0 * 512 + hb * 128, (const bf16_t*)(w + WS_VB) + (size_t)kr0 * 512 + hb * 128, seq, br * 128,
                                      0.125f * 1.4426950408889634f, attl, o);
                    __syncthreads();
                    LAS float* st = (LAS float*)lds + ws4 * 4096;
                    if (br == 1) {
#pragma unroll
                        for (int d0 = 0; d0 < 4; ++d0)
#pragma unroll
                            for (int r = 0; r < 16; ++r) st[(d0 * 16 + r) * 64 + lane] = o[d0][r];
                    }
                    __syncthreads();
                    if (br == 0) {
                        const float lam = *((const float*)(w + WS_LAM) + l), oml = 1.f - (0.8f - 0.6f * expf(-0.3f * (float)l));
                        float sq[16];
#pragma unroll
                        for (int r = 0; r < 16; ++r) { float sm = 0.f;
#pragma unroll
                            for (int d0 = 0; d0 < 4; ++d0) { const float v = o[d0][r] - lam * st[(d0 * 16 + r) * 64 + lane]; o[d0][r] = v; sm += v * v; }
                            sq[r] = sm; }
#pragma unroll
                        for (int r = 0; r < 16; ++r) { float sm = sq[r];
#pragma unroll
                            for (int off = 1; off < 32; off <<= 1) sm += __shfl_xor(sm, off);
                            sq[r] = rsqrtf(sm * (1.f / 128.f) + EPS) * oml; }
                        const float* sg = (const float*)(w + WS_SMALL) + SP_SUB + l * 128;
                        float gs[4];
#pragma unroll
                        for (int d0 = 0; d0 < 4; ++d0) gs[d0] = sg[d0 * 32 + r32];
#pragma unroll
                        for (int r = 0; r < 16; ++r) { const int orow = tok0 + ws4 * 32 + att::crow(r, hi);
#pragma unroll
                            for (int d0 = 0; d0 < 4; ++d0) MIX[(size_t)orow * DM + 1024 + hb * 128 + d0 * 32 + r32] = (bf16_t)(cvt_pk_bf16(o[d0][r] * sq[r] * gs[d0], 0.f) & 0xffff); }
                    }
                    __syncthreads();
                }
            }
        }
        GSYNC();
        {
            unsigned char* w = opaque(ws0);
            pg8::Gemm g{(const bf16_t*)(w + WS_MIX), (const bf16_t*)(w + WS_WOUT) + (size_t)l * DM * DM, T, DM, DM}; pg8::StaticOrder S; S.init(T, DM, G, bid);
            if (l == 0) { EpiRes<true, false> E{ws0, out0, p.in[0], p.in[1], l * 5 * 12288 + 2 * DM, SP_N2 + l * DM, l * 5 * 12288 + 4 * DM, 2 * l + 1};
                pg8::gemm_phase<EpiRes<true, false>, pg8::StaticOrder, false, true>(lds, g, S, E); }
            else { EpiRes<false, false> E{ws0, out0, nullptr, nullptr, l * 5 * 12288 + 2 * DM, SP_N2 + l * DM, l * 5 * 12288 + 4 * DM, 2 * l + 1};
                pg8::gemm_phase<EpiRes<false, false>, pg8::StaticOrder, false, true>(lds, g, S, E); }
        }
        GSYNC();
        {
            unsigned char* w = opaque(ws0);
            pg8::Gemm g{(const bf16_t*)(w + WS_XA), (const bf16_t*)(w + WS_WGU) + (size_t)l * NGU * DM, T, NGU, DM}; pg8::StaticOrder S; S.init(T, NGU, G, bid);
            EpiGU E{ws0, l};
            pg8::gemm_phase<EpiGU, pg8::StaticOrder, true, true>(lds, g, S, E);
        }
        GSYNC();
        {
            TIDS();
            unsigned char* w = opaque(ws0);
            const float* EDGE = (const float*)(w + WS_EDGE); const float* cw = (const float*)(w + WS_SMALL) + SP_CW + (size_t)l * 3 * DFF; bf16_t* HFF = (bf16_t*)(w + WS_HFF);
            for (long i = gtid; i < 128L * DFF; i += NGT) {
                const int e = (int)(i / DFF), ch = (int)(i % DFF), pml = e >> 1, side = e & 1;
                const bool interior = side == 0 ? ((pml & 15) != 0) : ((pml & 15) != 15);
                if (!interior) continue;
                const float* me = EDGE + (size_t)(e * 3) * DFF;
                const float* ot = EDGE + (size_t)(((side == 0 ? pml - 1 : pml + 1) * 2 + (1 - side)) * 3 + 1) * DFF;
                const float wv = cw[(side == 0 ? 0 : 2) * DFF + ch];
                const float cvv = me[ch] + wv * ot[ch];
                const float h = silu_f(cvv) * me[2 * DFF + ch];
                const int row = NCTX + pml * 256 + (side ? 255 : 0);
                HFF[blk(row, ch, 88)] = (bf16_t)(cvt_pk_bf16(h, 0.f) & 0xffff);
            }
        }
        GSYNC();
        {
            unsigned char* w = opaque(ws0);
            pg8::Gemm g{(const bf16_t*)(w + WS_HFF), (const bf16_t*)(w + WS_WDN) + (size_t)l * DM * DFF, T, DM, DFF}; pg8::StaticOrder S; S.init(T, DM, G, bid);
            if (l == 0) { EpiRes<false, false> E{ws0, out0, nullptr, nullptr, l * 5 * 12288 + 5 * DM, SP_N1 + DM, 5 * 12288 + 1 * DM, 2 * l + 2};
                pg8::gemm_phase<EpiRes<false, false>, pg8::StaticOrder, true, true>(lds, g, S, E); }
            else if (G == 256) { EpiRes<false, true> E{ws0, out0, nullptr, nullptr, l * 5 * 12288 + 5 * DM, SP_FIN, 0, 2 * l + 2}; pg8::PanelOrder SP{bid, G};
                pg8::gemm_phase<EpiRes<false, true>, pg8::PanelOrder, true, true>(lds, g, SP, E); }
            else { EpiRes<false, false, true> E{ws0, out0, nullptr, nullptr, l * 5 * 12288 + 5 * DM, -1, 5 * 12288 + 1 * DM, 2 * l + 2};
                pg8::gemm_phase<EpiRes<false, false, true>, pg8::StaticOrder, true, true>(lds, g, S, E); }
        }
        if (l == 0 || G != 256) GSYNC();
    }
    if (G != 256) {
        TIDS();
        unsigned char* w = opaque(ws0); float* X = opaque(out0);
        const float* SS = (const float*)(w + WS_SS) + (size_t)4 * T; const float* fin_g = (const float*)(w + WS_SMALL) + SP_FIN;
        for (int row = gw; row < T; row += NGW) {
            const float rs = rsqrtf(SS[row] * (1.f / DM) + EPS);
            float* xr = X + (size_t)row * DM;
#pragma unroll
            for (int j = 0; j < 8; ++j) { const int c = j * 256 + lane * 4; const f32x4 x = *(const f32x4*)(xr + c); *(f32x4*)(xr + c) = x * rs * *(const f32x4*)(fin_g + c); }
        }
    }
}

extern "C" void kernel_launch(void* const* d_in, const int* in_sizes, int n_in, void* d_out, int out_size, void* d_ws, size_t ws_size, hipStream_t stream) {
    static int grid_blocks = 0;
    if (grid_blocks == 0) {
        int dev = 0, cus = 0, per_cu = 0;
        if (n_in != 27 || ws_size < WS_END) { fprintf(stderr, "kernel_launch: n_in %d ws %zu (need %zu)\n", n_in, ws_size, (size_t)WS_END); grid_blocks = -1; return; }
        (void)hipGetDevice(&dev);
        (void)hipDeviceGetAttribute(&cus, hipDeviceAttributeMultiprocessorCount, dev);
        (void)hipFuncSetAttribute((const void*)fwd_megakernel, hipFuncAttributeMaxDynamicSharedMemorySize, LDS_BYTES);
        (void)hipOccupancyMaxActiveBlocksPerMultiprocessor(&per_cu, (const void*)fwd_megakernel, 512, LDS_BYTES);
        (void)hipGetLastError();
        grid_blocks = cus > 0 ? cus : 256;
        fprintf(stderr, "kernel_launch: cus %d per_cu %d grid %d ws %zu\n", cus, per_cu, grid_blocks, ws_size);
    }
    if (grid_blocks < 0) return;
    Params p{};
    for (int i = 0; i < 27; ++i) p.in[i] = (const float*)d_in[i];
    p.out = (float*)d_out; p.ws = (unsigned char*)d_ws;
    void* args[] = {&p};
    hipError_t e = hipLaunchCooperativeKernel((const void*)fwd_megakernel, dim3(grid_blocks), dim3(512), args, LDS_BYTES, stream);
    if (e != hipSuccess) fprintf(stderr, "cooperative launch failed: %s (grid %d)\n", hipGetErrorString(e), grid_blocks);
}
```
